# Optimizing an MI355X kernel written in HIP

```python
import math
import jax
import jax.numpy as jnp
from jax import lax
import numpy as np

D_MODEL = 1024
BATCH = 32
SEQ = 256
DEPTH = 4
DEC_BATCH = 2
DEC_SEQ = 4096
PAST_LEN = 512

GRID_W = 64
N_GROUPS = 4
GROUP_W = D_MODEL // N_GROUPS
HEAD_DIM = 64
F32 = jnp.float32
HY_W = GROUP_W
HY_COLS = 3 * HY_W
HY_BANDS = 16
HY_EMB = 2 * HY_BANDS + 1
HY_FFN = 64
HY_TARGET = 1e-2
HY_MAX_DECAY = math.log(HY_TARGET) / 0.3
HY_MIN_DECAY = math.log(HY_TARGET) / 1.5
ML_HEADS = GROUP_W // HEAD_DIM
ML_CHUNK = 128
ML_COLS = 4 * GROUP_W + 4 * ML_HEADS
RW_HEADS = GROUP_W // HEAD_DIM
RW_W_RANK = 64
RW_A_RANK = 64
RW_G_RANK = 128
RW_DECAY_SCALE = 0.606531
RW_GN_EPS = 64e-5
RW_COLS = 3 * GROUP_W + RW_W_RANK + RW_A_RANK + RW_G_RANK
AT_HEADS = GROUP_W // HEAD_DIM
AT_KV_HEADS = 2
AT_BLOCK = 128
AT_COLS = (AT_HEADS + 2 * AT_KV_HEADS) * HEAD_DIM
ROPE_THETA = 10000.0
ROPE_AXIS = HEAD_DIM // 2
ROPE_FREQS = ROPE_AXIS // 2
P_IN = HY_COLS + ML_COLS + RW_COLS + AT_COLS
IN_SPLITS = (HY_COLS, HY_COLS + ML_COLS, HY_COLS + ML_COLS + RW_COLS)
ML_SPLITS = (GROUP_W, 2 * GROUP_W, 3 * GROUP_W, 4 * GROUP_W)
RW_SPLITS = (GROUP_W, 2 * GROUP_W, 3 * GROUP_W, 3 * GROUP_W + RW_W_RANK, 3 * GROUP_W + RW_W_RANK + RW_A_RANK)
AT_SPLITS = (AT_HEADS * HEAD_DIM, (AT_HEADS + AT_KV_HEADS) * HEAD_DIM)
D_FF = 4 * D_MODEL
ALPHA = (2.0 * DEPTH) ** 0.25
BETA = (8.0 * DEPTH) ** -0.25

kernel_name = 'hybrid_flow_hymba_step'


def _prev(x):
    return jnp.pad(x, ((0, 0), (1, 0), (0, 0)))[:, :-1]


def _next(x):
    return jnp.pad(x, ((0, 0), (0, 1), (0, 0)))[:, 1:]


def _dwconv3(x, w):
    return _prev(x) * w[0] + x * w[1] + _next(x) * w[2]


def _layernorm(x, g, b, eps=1e-5):
    xf = x.astype(F32)
    mu = jnp.mean(xf, -1, keepdims=True)
    var = jnp.mean(jnp.square(xf - mu), -1, keepdims=True)
    return ((xf - mu) * lax.rsqrt(var + eps) * g.astype(F32) + b.astype(F32)).astype(x.dtype)


def _rmsnorm(x, g, eps=1e-6):
    xf = x.astype(F32)
    return (xf * lax.rsqrt(jnp.mean(jnp.square(xf), -1, keepdims=True) + eps) * g.astype(F32)).astype(x.dtype)


def _head_norm(y, eps):
    mu = jnp.mean(y, -1, keepdims=True)
    var = jnp.mean(jnp.square(y - mu), -1, keepdims=True)
    return (y - mu) * lax.rsqrt(var + eps)


def _hyena_filters(L, w1, b1, freq, w2, b2, w3):
    t = jnp.linspace(0.0, 1.0, L, dtype=F32)[:, None]
    ang = (2.0 * math.pi / L) * jnp.arange(L, dtype=F32)[:, None]
    bands = jnp.linspace(1e-4, HY_BANDS - 1, HY_BANDS, dtype=F32)[None, :]
    z = jnp.concatenate([t, jnp.cos(bands * ang), jnp.sin(bands * ang)], axis=-1)
    fr = freq.astype(F32)
    hid = jnp.sin(fr * (z @ w1.astype(F32) + b1.astype(F32)))
    hid = jnp.sin(fr * (hid @ w2.astype(F32) + b2.astype(F32)))
    h = (hid @ w3.astype(F32)).reshape(L, 2, 2, HY_W)
    deltas = jnp.abs(jnp.linspace(HY_MIN_DECAY, HY_MAX_DECAY, HY_W, dtype=F32))
    h = h * jnp.exp(-t * deltas)[:, None, None, :]
    causal = h[:, :, 0]
    anti = h[1:, :, 1][::-1]
    filt = jnp.concatenate([causal, jnp.zeros((1, 2, HY_W), F32), anti], axis=0)
    return filt / jnp.sum(jnp.abs(filt), axis=0, keepdims=True)


def _long_conv(u, filt, bias):
    L = u.shape[1]
    uf = u.astype(F32)
    spec = jnp.fft.rfft(uf, n=2 * L, axis=1) * jnp.fft.rfft(filt, axis=0)[None]
    y = jnp.fft.irfft(spec, n=2 * L, axis=1)[:, :L]
    return (y + uf * bias.astype(F32)).astype(u.dtype)


def _hyena(p, conv_w, filt, bias):
    p = _dwconv3(p, conv_w)
    v, x1, x2 = jnp.split(p, 3, axis=-1)
    z = x1 * _long_conv(v, filt[:, 0], bias[0])
    return x2 * _long_conv(z, filt[:, 1], bias[1])


def _mlstm_scan(q, k, v, log_i, log_f, C0, n0, m0):
    B, L, H, Dh = q.shape
    nc = L // ML_CHUNK

    def to_chunks(a):
        a = a.reshape((B, nc, ML_CHUNK) + a.shape[2:])
        return jnp.moveaxis(jnp.moveaxis(a, 1, 0), 3, 2)

    tril = jnp.tril(jnp.ones((ML_CHUNK, ML_CHUNK), bool))

    def step(carry, inp):
        C, n, m = carry
        qc, kc, vc, ic, fc = inp
        b = jnp.cumsum(fc, axis=-1)
        logd = jnp.where(tril, b[..., :, None] - b[..., None, :] + ic[..., None, :], -jnp.inf)
        inter = b + m[..., None]
        m_t = jnp.maximum(inter, jnp.max(logd, axis=-1))
        s = jnp.einsum('bhtd,bhsd->bhts', qc, kc) * jnp.exp(logd - m_t[..., None])
        w_in = jnp.exp(inter - m_t)
        num = jnp.einsum('bhts,bhse->bhte', s, vc) + w_in[..., None] * jnp.einsum('bhtd,bhde->bhte', qc, C)
        den = jnp.sum(s, -1) + w_in * jnp.einsum('bhtd,bhd->bht', qc, n)
        h = num / jnp.maximum(jnp.abs(den), jnp.exp(-m_t))[..., None]
        b_last = b[..., -1]
        logw = b_last[..., None] - b + ic
        m_new = jnp.maximum(b_last + m, jnp.max(logw, axis=-1))
        wk = jnp.exp(logw - m_new[..., None])
        decay = jnp.exp(b_last + m - m_new)
        C_new = decay[..., None, None] * C + jnp.einsum('bhs,bhsd,bhse->bhde', wk, kc, vc)
        n_new = decay[..., None] * n + jnp.einsum('bhs,bhsd->bhd', wk, kc)
        return (C_new, n_new, m_new), h

    xs = (to_chunks(q), to_chunks(k), to_chunks(v), to_chunks(log_i), to_chunks(log_f))
    (C, n, m), h = lax.scan(step, (C0, n0, m0), xs)
    h = jnp.swapaxes(jnp.moveaxis(h, 0, 1), 2, 3).reshape(B, L, H, Dh)
    return h, C, n, m


def _mlstm(p, gate_b, norm_g, C0, n0, m0):
    B, L, _ = p.shape
    pf = p.astype(F32)
    q, k, v, o, g = jnp.split(pf, ML_SPLITS, axis=-1)
    hd = lambda t: t.reshape(B, L, ML_HEADS, HEAD_DIM)
    q, k, v = hd(q) * (HEAD_DIM ** -0.5), hd(k), hd(v)
    g = (g + gate_b.astype(F32)).reshape(B, L, 2, 2, ML_HEADS)
    log_i = g[:, :, :, 0]
    log_f = jax.nn.log_sigmoid(g[:, :, :, 1])
    h_f, Cf, nf, mf = _mlstm_scan(q, k, v, log_i[:, :, 0], log_f[:, :, 0],
                                  C0[:, 0].astype(F32), n0[:, 0].astype(F32), m0[:, 0].astype(F32))
    fl = lambda t: jnp.flip(t, axis=1)
    h_b, Cb, nb, mb = _mlstm_scan(fl(q), fl(k), fl(v), fl(log_i[:, :, 1]), fl(log_f[:, :, 1]),
                                  C0[:, 1].astype(F32), n0[:, 1].astype(F32), m0[:, 1].astype(F32))
    h = _head_norm(h_f + fl(h_b), 1e-6).reshape(B, L, GROUP_W) * norm_g.astype(F32)
    out = (h * jax.nn.sigmoid(o)).astype(p.dtype)
    return out, jnp.stack([Cf, Cb], 1), jnp.stack([nf, nb], 1), jnp.stack([mf, mb], 1)


def _rwkv_scan(r, w, k, v, a_vec, b_vec, S0, reverse):
    def step(S, inp):
        r_t, w_t, k_t, v_t, a_t, b_t = inp
        sa = jnp.einsum('bhvk,bhk->bhv', S, a_t)
        S = S * w_t[:, :, None, :] + sa[..., None] * b_t[:, :, None, :] + v_t[..., :, None] * k_t[:, :, None, :]
        return S, jnp.einsum('bhvk,bhk->bhv', S, r_t)

    xs = tuple(jnp.moveaxis(t, 1, 0) for t in (r, w, k, v, a_vec, b_vec))
    S, ys = lax.scan(step, S0, xs, reverse=reverse)
    return S, jnp.moveaxis(ys, 0, 1)


def _rwkv(p, lp, S0):
    B, L, _ = p.shape
    f = lambda name: lp[name].astype(F32)
    pf = p.astype(F32)
    pf = pf + f('rw_mu') * (0.5 * (_prev(pf) + _next(pf)) - pf)
    r, k, v, lw, la, lg = jnp.split(pf, RW_SPLITS, axis=-1)
    hd = lambda t: t.reshape(B, L, RW_HEADS, HEAD_DIM)
    g = jax.nn.sigmoid(lg) @ f('rw_g2')
    kk = hd(k * f('rw_kk'))
    kk = kk / jnp.maximum(jnp.linalg.norm(kk, axis=-1, keepdims=True), 1e-12)
    tw = jnp.tanh(lw)
    rh, vh = hd(r), hd(v)
    rk = f('rw_rk').reshape(RW_HEADS, HEAD_DIM)
    scans, bonus, states = [], [], []
    for d in range(2):
        w = jnp.exp(-RW_DECAY_SCALE * jax.nn.sigmoid(f('rw_w0')[d] + tw @ f('rw_w2')[d]))
        a = jax.nn.sigmoid(f('rw_a0')[d] + la @ f('rw_a2')[d])
        kt = hd(k * (1.0 + (a - 1.0) * f('rw_ka')))
        S, y = _rwkv_scan(rh, hd(w), kt, vh, -kk, kk * hd(a), S0[:, d].astype(F32), d == 1)
        scans.append(y)
        bonus.append(jnp.sum(rh * kt * rk, axis=-1, keepdims=True) * vh)
        states.append(S)
    y = _head_norm(scans[0] + scans[1], RW_GN_EPS).reshape(B, L, GROUP_W) * f('rw_ln_g') + f('rw_ln_b')
    y = y + (bonus[0] + bonus[1]).reshape(B, L, GROUP_W)
    return (y * g).astype(p.dtype), jnp.stack(states, axis=1)


def _rope_2d(x):
    L = x.shape[1]
    rows = L // GRID_W
    pos_r = jnp.repeat(jnp.arange(rows, dtype=F32), GRID_W)
    pos_c = jnp.tile(jnp.arange(GRID_W, dtype=F32), rows)
    inv = ROPE_THETA ** (-jnp.arange(ROPE_FREQS, dtype=F32) / ROPE_FREQS)

    def rot(xa, pos):
        ang = pos[:, None] * inv[None, :]
        cos = jnp.cos(ang)[None, :, None, :]
        sin = jnp.sin(ang)[None, :, None, :]
        x1, x2 = xa[..., :ROPE_FREQS], xa[..., ROPE_FREQS:]
        return jnp.concatenate([x1 * cos - x2 * sin, x1 * sin + x2 * cos], -1)

    xf = x.astype(F32)
    return jnp.concatenate([rot(xf[..., :ROPE_AXIS], pos_r), rot(xf[..., ROPE_AXIS:], pos_c)], -1).astype(x.dtype)


def _attend_blocks(q, k, v):
    B, Lq, H, Dh = q.shape
    kvh = k.shape[2]
    G = H // kvh
    qb = jnp.moveaxis(q.reshape(B, Lq // AT_BLOCK, AT_BLOCK, kvh, G, Dh), 1, 0)

    def one(qblk):
        s = jnp.einsum('btkgd,bskd->bkgts', qblk, k).astype(F32) * (Dh ** -0.5)
        prob = jax.nn.softmax(s, axis=-1)
        return jnp.einsum('bkgts,bskd->btkgd', prob.astype(v.dtype), v)

    o = lax.map(one, qb)
    return jnp.moveaxis(o, 0, 1).reshape(B, Lq, H * Dh)


def _attn(p, qn, kn, ctx_kv):
    B, L, _ = p.shape
    q, k, v = jnp.split(p, AT_SPLITS, axis=-1)
    q = _rmsnorm(q.reshape(B, L, AT_HEADS, HEAD_DIM), qn)
    k = _rmsnorm(k.reshape(B, L, AT_KV_HEADS, HEAD_DIM), kn)
    v = v.reshape(B, L, AT_KV_HEADS, HEAD_DIM)
    if ctx_kv is None:
        return _attend_blocks(q, k, v).astype(p.dtype), k, v
    q, k = _rope_2d(q), _rope_2d(k)
    kc, vc = ctx_kv
    keys = jnp.concatenate([k, kc.astype(k.dtype)], axis=1)
    vals = jnp.concatenate([v, vc.astype(v.dtype)], axis=1)
    return _attend_blocks(q, keys, vals).astype(p.dtype), k, v


def _layer(x, mod, lp, ctx):
    B, L, _ = x.shape
    sh_a, sc_a, g_a, sh_m, sc_m, g_m = jnp.split(mod[:, None, :].astype(x.dtype), 6, axis=-1)
    h = x * (1 + sc_a) + sh_a
    p = h @ lp['w_in']
    p_hy, p_ml, p_rw, p_at = jnp.split(p, IN_SPLITS, axis=-1)
    filt = _hyena_filters(L, lp['hy_w1'], lp['hy_b1'], lp['hy_freq'], lp['hy_w2'], lp['hy_b2'], lp['hy_w3'])
    y_hy = _hyena(p_hy, lp['hy_conv'], filt, lp['hy_bias'])
    if ctx is None:
        C0 = jnp.zeros((B, 2, ML_HEADS, HEAD_DIM, HEAD_DIM), F32)
        n0 = jnp.zeros((B, 2, ML_HEADS, HEAD_DIM), F32)
        m0 = jnp.zeros((B, 2, ML_HEADS), F32)
        S0 = jnp.zeros((B, 2, RW_HEADS, HEAD_DIM, HEAD_DIM), F32)
        kv = None
    else:
        kc, vc, C0, n0, m0, S0 = ctx
        kv = (kc, vc)
    y_ml, C, n, m = _mlstm(p_ml, lp['ml_gate_b'], lp['ml_norm_g'], C0, n0, m0)
    y_rw, S = _rwkv(p_rw, lp, S0)
    y_at, k, v = _attn(p_at, lp['at_qn'], lp['at_kn'], kv)
    mix = jnp.concatenate([y_hy, y_ml, y_rw, y_at], axis=-1) @ lp['w_out']
    x = _layernorm(ALPHA * x + g_a * mix, lp['ln1_g'], lp['ln1_b'])
    h = x * (1 + sc_m) + sh_m
    ff = jnp.square(jax.nn.relu(h @ lp['mlp_w1'])) @ lp['mlp_w2']
    x = _layernorm(ALPHA * x + g_m * ff, lp['ln2_g'], lp['ln2_b'])
    return x, (k, v, C, n, m, S)


def setup_inputs(seed: int = 0) -> dict:
    key = jax.random.key(seed)
    ks = iter(jax.random.split(key, 64))
    nrm = lambda shape, scale: scale * jax.random.normal(next(ks), shape, F32)
    D = D_MODEL
    W = GROUP_W
    gate_off = jnp.concatenate([jnp.zeros(2 * D), jnp.ones(D), jnp.zeros(2 * D), jnp.ones(D)]).astype(F32)
    ml_off = jnp.concatenate([jnp.zeros(ML_HEADS), jnp.linspace(3.0, 6.0, ML_HEADS)] * 2).astype(F32)
    conv_off = jnp.array([0.0, 1.0, 0.0], F32)[:, None]
    return {
        'x_prompt': nrm((BATCH, SEQ, D), 1.0),
        'x_sample': nrm((DEC_BATCH, DEC_SEQ, D), 1.0),
        'cache_attn_k': nrm((DEC_BATCH, DEPTH, PAST_LEN, AT_KV_HEADS, HEAD_DIM), 1.0),
        'cache_attn_v': nrm((DEC_BATCH, DEPTH, PAST_LEN, AT_KV_HEADS, HEAD_DIM), 1.0),
        'state_mlstm_C': nrm((DEC_BATCH, DEPTH, 2, ML_HEADS, HEAD_DIM, HEAD_DIM), 0.3),
        'state_mlstm_n': nrm((DEC_BATCH, DEPTH, 2, ML_HEADS, HEAD_DIM), 0.3),
        'state_mlstm_m': nrm((DEC_BATCH, DEPTH, 2, ML_HEADS), 0.5),
        'state_rwkv_S': nrm((DEC_BATCH, DEPTH, 2, RW_HEADS, HEAD_DIM, HEAD_DIM), 0.3),
        'c': nrm((DEC_BATCH, D), 1.0),
        'c_ctx': nrm((D,), 1.0),
        'w_mod': nrm((DEPTH, D, 6 * D), 0.1 * D ** -0.5),
        'b_mod': nrm((DEPTH, 6 * D), 0.02) + gate_off,
        'w_in': nrm((DEPTH, D, P_IN), D ** -0.5),
        'hy_conv': nrm((DEPTH, 3, HY_COLS), 0.3) + conv_off,
        'hy_w1': nrm((DEPTH, HY_EMB, HY_FFN), HY_EMB ** -0.5),
        'hy_b1': nrm((DEPTH, HY_FFN), 0.1),
        'hy_freq': 1.0 + nrm((DEPTH, HY_FFN), 0.02),
        'hy_w2': nrm((DEPTH, HY_FFN, HY_FFN), HY_FFN ** -0.5),
        'hy_b2': nrm((DEPTH, HY_FFN), 0.1),
        'hy_w3': nrm((DEPTH, HY_FFN, 4 * HY_W), HY_FFN ** -0.5),
        'hy_bias': nrm((DEPTH, 2, HY_W), 0.1),
        'ml_gate_b': nrm((DEPTH, 4 * ML_HEADS), 0.1) + ml_off,
        'ml_norm_g': 1.0 + nrm((DEPTH, W), 0.02),
        'rw_mu': 0.5 + nrm((DEPTH, RW_COLS), 0.1),
        'rw_w0': nrm((DEPTH, 2, W), 0.5),
        'rw_w2': nrm((DEPTH, 2, RW_W_RANK, W), 0.1 * RW_W_RANK ** -0.5),
        'rw_a0': nrm((DEPTH, 2, W), 0.5),
        'rw_a2': nrm((DEPTH, 2, RW_A_RANK, W), 0.1 * RW_A_RANK ** -0.5),
        'rw_g2': nrm((DEPTH, RW_G_RANK, W), RW_G_RANK ** -0.5),
        'rw_kk': 1.0 + nrm((DEPTH, W), 0.1),
        'rw_ka': 1.0 + nrm((DEPTH, W), 0.1),
        'rw_rk': nrm((DEPTH, W), 0.1),
        'rw_ln_g': 1.0 + nrm((DEPTH, W), 0.02),
        'rw_ln_b': nrm((DEPTH, W), 0.02),
        'at_qn': 1.0 + nrm((DEPTH, HEAD_DIM), 0.02),
        'at_kn': 1.0 + nrm((DEPTH, HEAD_DIM), 0.02),
        'w_out': nrm((DEPTH, D, D), BETA * D ** -0.5),
        'ln1_g': 1.0 + nrm((DEPTH, D), 0.02),
        'ln1_b': nrm((DEPTH, D), 0.02),
        'mlp_w1': nrm((DEPTH, D, D_FF), D ** -0.5),
        'mlp_w2': nrm((DEPTH, D_FF, D), BETA * D_FF ** -0.5),
        'ln2_g': 1.0 + nrm((DEPTH, D), 0.02),
        'ln2_b': nrm((DEPTH, D), 0.02),
    }


def reference(x_prompt, x_sample, cache_attn_k, cache_attn_v, state_mlstm_C, state_mlstm_n, state_mlstm_m,
              state_rwkv_S, c, c_ctx, w_mod, b_mod, w_in, hy_conv, hy_w1, hy_b1, hy_freq, hy_w2, hy_b2, hy_w3,
              hy_bias, ml_gate_b, ml_norm_g, rw_mu, rw_w0, rw_w2, rw_a0, rw_a2, rw_g2, rw_kk, rw_ka, rw_rk,
              rw_ln_g, rw_ln_b, at_qn, at_kn, w_out, ln1_g, ln1_b, mlp_w1, mlp_w2, ln2_g, ln2_b):
    params = {
        'w_in': w_in, 'hy_conv': hy_conv, 'hy_w1': hy_w1, 'hy_b1': hy_b1, 'hy_freq': hy_freq,
        'hy_w2': hy_w2, 'hy_b2': hy_b2, 'hy_w3': hy_w3, 'hy_bias': hy_bias,
        'ml_gate_b': ml_gate_b, 'ml_norm_g': ml_norm_g,
        'rw_mu': rw_mu, 'rw_w0': rw_w0, 'rw_w2': rw_w2, 'rw_a0': rw_a0, 'rw_a2': rw_a2, 'rw_g2': rw_g2,
        'rw_kk': rw_kk, 'rw_ka': rw_ka, 'rw_rk': rw_rk, 'rw_ln_g': rw_ln_g, 'rw_ln_b': rw_ln_b,
        'at_qn': at_qn, 'at_kn': at_kn, 'w_out': w_out, 'ln1_g': ln1_g, 'ln1_b': ln1_b,
        'mlp_w1': mlp_w1, 'mlp_w2': mlp_w2, 'ln2_g': ln2_g, 'ln2_b': ln2_b,
    }
    x = x_prompt
    ctx_states = []
    for l in range(DEPTH):
        lp = {name: arr[l] for name, arr in params.items()}
        mod = jax.nn.silu(c_ctx)[None, :] @ w_mod[l] + b_mod[l]
        x, st = _layer(x, mod, lp, None)
        ctx_states.append(st)
    y_prompt = x
    new_attn_k = jnp.stack([st[0] for st in ctx_states], axis=1)
    new_attn_v = jnp.stack([st[1] for st in ctx_states], axis=1)
    new_mlstm_C = jnp.stack([st[2] for st in ctx_states], axis=1)
    new_mlstm_n = jnp.stack([st[3] for st in ctx_states], axis=1)
    new_mlstm_m = jnp.stack([st[4] for st in ctx_states], axis=1)
    new_rwkv_S = jnp.stack([st[5] for st in ctx_states], axis=1)
    x = x_sample
    for l in range(DEPTH):
        lp = {name: arr[l] for name, arr in params.items()}
        mod = jax.nn.silu(c) @ w_mod[l] + b_mod[l]
        ctx = (cache_attn_k[:, l], cache_attn_v[:, l], state_mlstm_C[:, l], state_mlstm_n[:, l],
               state_mlstm_m[:, l], state_rwkv_S[:, l])
        x, _ = _layer(x, mod, lp, ctx)
    y_sample = x
    return (y_prompt, y_sample, new_attn_k, new_attn_v, new_mlstm_C, new_mlstm_n, new_mlstm_m, new_rwkv_S)
```

```cpp
#include <hip/hip_runtime.h>
#include <hip/hip_cooperative_groups.h>
#include <cstdio>
#include <cstdint>
#include <cmath>
namespace cg = cooperative_groups;

constexpr int DM = 1024, NTOK = 16384, NCTX = 8192, PIN = 3344, PINP = 3584, DFF = 4096, DEPTH = 4;
constexpr int C_HY = 0, C_ML = 768, C_RW = 1808, C_AT = 2832;
constexpr int C_MLG = C_ML + 1024;
constexpr float ALPHA = 1.6817928305074290f;
constexpr float QSCALE = 0.125f * 1.4426950408889634f;
constexpr int NTHR = 512, NWAVE = 8;

constexpr size_t MiB = 1u << 20;
constexpr size_t WS_CTL = 0;
constexpr size_t WS_MOD = 1 * MiB;
constexpr size_t WS_ROPE = WS_MOD + 512 * 1024;
constexpr size_t WS_WIN = 2 * MiB;
constexpr size_t WS_WOUT = WS_WIN + 7 * MiB;
constexpr size_t WS_W1 = WS_WOUT + 2 * MiB;
constexpr size_t WS_W2 = WS_W1 + 8 * MiB;
constexpr size_t WS_P = WS_W2 + 8 * MiB;
constexpr size_t WS_H = WS_P + 128 * MiB;
constexpr size_t WS_YC = WS_H + 32 * MiB;
constexpr size_t WS_FILT = WS_YC + 32 * MiB;
constexpr size_t FILT_LAT_OFF = 2 * 256 * 512 * 2;
constexpr size_t WS_PART = WS_FILT + 9 * MiB;
constexpr size_t WS_XT = WS_PART + 1 * MiB;
constexpr size_t WS_QB = WS_XT + 24 * MiB;
constexpr size_t WS_KBC = WS_QB + 8 * MiB;
constexpr size_t WS_VTC = WS_KBC + 2 * MiB;
constexpr size_t WS_KBL = WS_VTC + 2 * MiB;
constexpr size_t WS_VTL = WS_KBL + 3 * MiB;
constexpr size_t WS_MLS = WS_VTL + 3 * MiB;
constexpr int MLS_STRIDE = 4224;
constexpr size_t WS_RWP = WS_MLS + 17 * MiB;
constexpr size_t WS_RWB = WS_RWP + 16 * MiB;
constexpr size_t WS_RWY = WS_RWB + 16 * MiB;
constexpr size_t WS_END = WS_RWY + 32 * MiB;
static_assert(WS_END <= 400 * MiB, "workspace map");

constexpr int CW_Q = 64;

typedef unsigned short bf16;
typedef unsigned u32x4 __attribute__((ext_vector_type(4)));
typedef unsigned u32x2 __attribute__((ext_vector_type(2)));
typedef float f32x4 __attribute__((ext_vector_type(4)));
typedef float f32x16 __attribute__((ext_vector_type(16)));
typedef short bf16x8 __attribute__((ext_vector_type(8)));

__device__ __forceinline__ float bf2f(unsigned u) { return __uint_as_float(u << 16); }
__device__ __forceinline__ unsigned f2bf(float f) { unsigned u = __float_as_uint(f); return (u + 0x7fffu + ((u >> 16) & 1u)) >> 16; }
__device__ __forceinline__ unsigned pk2(float lo, float hi) { return f2bf(lo) | (f2bf(hi) << 16); }
__device__ __forceinline__ float lo16(unsigned w) { return __uint_as_float(w << 16); }
__device__ __forceinline__ float hi16(unsigned w) { return __uint_as_float(w & 0xffff0000u); }
__device__ __forceinline__ float wave_sum(float v) {
#pragma unroll
    for (int o = 1; o < 64; o <<= 1) v += __shfl_xor(v, o);
    return v;
}
__device__ __forceinline__ float wave_max(float v) {
#pragma unroll
    for (int o = 1; o < 64; o <<= 1) v = fmaxf(v, __shfl_xor(v, o));
    return v;
}
__device__ __forceinline__ float sigmoidf_(float x) { return 1.0f / (1.0f + __expf(-x)); }
__device__ __forceinline__ float logsigmoidf_(float x) { return fminf(x, 0.f) - log1pf(__expf(-fabsf(x))); }
__device__ __forceinline__ void unpack8(const u32x4 w, float* f) {
    f[0] = lo16(w.x); f[1] = hi16(w.x); f[2] = lo16(w.y); f[3] = hi16(w.y); f[4] = lo16(w.z); f[5] = hi16(w.z); f[6] = lo16(w.w); f[7] = hi16(w.w);
}

struct Args {
    const float* in[43];
    float* out;
    unsigned char* ws;
    int ph_lo, ph_hi;
};
constexpr int LDS_BYTES = 147456;
constexpr int LDS_SLOT = LDS_BYTES - 16;
constexpr int LDS_TAB = LDS_BYTES - 512;
struct KA {
    float* out; unsigned char* ws; const unsigned char* lds;
    __device__ __forceinline__ const float* in(int i) const {
        const u32x2 v = *(const u32x2*)(lds + LDS_TAB + i * 8);
        const unsigned lo = __builtin_amdgcn_readfirstlane(v.x), hi = __builtin_amdgcn_readfirstlane(v.y);
        return (const float*)(((unsigned long long)hi << 32) | lo);
    }
};
namespace pg8 {
#define PG8_LAS __attribute__((address_space(3)))
typedef unsigned short bf16_t;
typedef short bf16x8 __attribute__((ext_vector_type(8)));
typedef float f32x4 __attribute__((ext_vector_type(4)));
typedef unsigned u32x4 __attribute__((ext_vector_type(4)));
constexpr int BM = 256, BK = 64, HALF = 128, HTB = HALF * BK * 2  , STAGE_BYTES = 8 * HTB, NXCD = 8, WGM = 8;

__host__ __device__ __forceinline__ int lds_byte(int r, int c) { const int st = (r >> 4) * 2 + (c >> 5), rr = r & 15, cc = c & 31, ob = rr * 64 + cc * 2; return st * 1024 + (ob ^ (((ob >> 9) & 1) << 5)); }
__host__ __device__ __forceinline__ void stage_rc(int b, int& R, int& C) { const int st = b / 1024, sb = b % 1024, swz = sb ^ (((sb >> 9) & 1) << 5); R = (st >> 1) * 16 + swz / 64; C = (st & 1) * 32 + (swz % 64) / 2; }
__host__ __device__ __forceinline__ int perm32(int rho) { const int n = rho >> 4, i = rho & 15; return 8 * (i >> 2) + 4 * n + (i & 3); }

struct Unit { int pm, pn; };
struct Gemm { const bf16_t* A; const bf16_t* Bt; int M, N, K; };

struct StaticOrder {
    int nM, nN, nwg, G, c;
    __host__ __device__ void init(int M, int N, int G_, int c_) { nM = M / BM; nN = N / BM; nwg = nM * nN; G = G_; c = c_; }
    __host__ __device__ bool next(int i, Unit& u) const {
        const long L = (long)i * G + c; if (L >= nwg) return false;
        int wgid = (int)L; { const int q = nwg / NXCD, r = nwg % NXCD, xcd = wgid % NXCD, off = wgid / NXCD; wgid = (xcd < r ? xcd * (q + 1) : r * (q + 1) + (xcd - r) * q) + off; }
        const int nig = WGM * nN, gid = wgid / nig, fm = gid * WGM, gsz = (nM - fm) < WGM ? (nM - fm) : WGM;
        u.pm = fm + ((wgid % nig) % gsz); u.pn = (wgid % nig) / gsz; return true;
    }
    __device__ __forceinline__ void a_ready(const Unit&) const {}
    __device__ __forceinline__ void done(const Unit&) const {}
};


__device__ __forceinline__ unsigned cvt_pk_bf16(float lo, float hi) { unsigned r; asm volatile("v_cvt_pk_bf16_f32 %0, %1, %2" : "=v"(r) : "v"(lo), "v"(hi)); return r; }

template <int ACT  > struct EpiBf16 {
    static constexpr bool PERM = true, AFTER_DRAIN = false;
    bf16_t* O; int ldc;
    __device__ __forceinline__ void operator()(const f32x4 (&acc)[2][2][4][2], const Unit& u, int wr, int wc, int fr, int fq) const {
        const int row0 = u.pm * BM + wr * 64 + fr; const int col0 = u.pn * BM + wc * 32 + 8 * fq;
#pragma unroll
        for (int ai = 0; ai < 2; ++ai)
#pragma unroll
            for (int m = 0; m < 4; ++m) { bf16_t* rowp = O + (size_t)(row0 + ai * HALF + m * 16) * ldc + col0;
#pragma unroll
                for (int bj = 0; bj < 2; ++bj) { f32x4 v0 = acc[ai][bj][m][0], v1 = acc[ai][bj][m][1];
                    if (ACT == 2) {
#pragma unroll
                        for (int e = 0; e < 4; ++e) { float a = fmaxf(v0[e], 0.f), b = fmaxf(v1[e], 0.f); v0[e] = a * a; v1[e] = b * b; } }
                    u32x4 w; w.x = cvt_pk_bf16(v0[0], v0[1]); w.y = cvt_pk_bf16(v0[2], v0[3]); w.z = cvt_pk_bf16(v1[0], v1[1]); w.w = cvt_pk_bf16(v1[2], v1[3]);
                    *(u32x4*)(rowp + bj * HALF) = w; } }
    }
};
struct EpiRes {
    static constexpr bool PERM = false, AFTER_DRAIN = false;
    const float* base0; const float* base1; float* out; const float* gate; float alpha;
    __device__ __forceinline__ void operator()(const f32x4 (&acc)[2][2][4][2], const Unit& u, int wr, int wc, int fr, int fq) const {
        const int cond = u.pm < 32 ? 0 : 1 + ((u.pm - 32) >> 4);
        const float* g = gate + cond * 6144;
        const float* bs = u.pm < 32 ? base0 : base1 - (size_t)8192 * 1024;
        const int col0 = u.pn * BM + wc * 32 + 4 * fq;
        f32x4 gv[2][2];
#pragma unroll
        for (int bj = 0; bj < 2; ++bj)
#pragma unroll
            for (int n = 0; n < 2; ++n) gv[bj][n] = *(const f32x4*)(g + col0 + bj * HALF + n * 16);
#pragma unroll
        for (int ai = 0; ai < 2; ++ai)
#pragma unroll
            for (int m = 0; m < 4; ++m) { const size_t off = (size_t)(u.pm * BM + ai * HALF + wr * 64 + m * 16 + fr) * 1024 + col0;
#pragma unroll
                for (int bj = 0; bj < 2; ++bj)
#pragma unroll
                    for (int n = 0; n < 2; ++n) { const f32x4 b = *(const f32x4*)(bs + off + bj * HALF + n * 16);
                        *(f32x4*)(out + off + bj * HALF + n * 16) = b * alpha + gv[bj][n] * acc[ai][bj][m][n]; } }
    }
};
template <class Epi, class Sched, bool ALIGN_EPI = false, bool SP2 = false>
__device__ __forceinline__ void gemm_phase(PG8_LAS unsigned char* lds, const Gemm g, const Sched& S, const Epi& E) {
    int tid_ = threadIdx.x; asm volatile("" : "+v"(tid_)); const int tid = tid_, wid = __builtin_amdgcn_readfirstlane(tid >> 6), lane = tid & 63, wr = wid >> 2, wc = wid & 3, fr = lane & 15, fq = lane >> 4;
    const int K = g.K, nt = K / BK;
    unsigned voffA[2], voffB[2];
#pragma unroll
    for (int i = 0; i < 2; ++i) { int R, C; stage_rc(tid * 16 + i * 8192, R, C); const int Rb = Epi::PERM ? ((R & ~31) + perm32(R & 31)) : R;
        voffA[i] = (unsigned)(R * K + C) * 2u; voffB[i] = (unsigned)(Rb * K + C) * 2u; }
    const size_t kstep = (size_t)(BK * 2);
    const size_t hstep = (size_t)HALF * K * 2;
    const size_t tstep = 2 * hstep;
    const unsigned ldsw = (unsigned)wid * 1024u;
    const int aoff = lds_byte(wr * 64 + fr, fq * 8), boff = lds_byte(wc * 32 + fr, fq * 8);
#define PG8_SA(b, h) (((b) * 2 + (h)) * HTB)
#define PG8_SB(b, h) ((4 + (b) * 2 + (h)) * HTB)
#define PG8_STAGE(bufoff, gbase, voff) do { _Pragma("unroll") for (int _i = 0; _i < 2; ++_i) \
        __builtin_amdgcn_global_load_lds((const unsigned*)((const char*)(gbase) + (voff)[_i]), (PG8_LAS unsigned*)(lds + (bufoff) + ldsw + _i * 8192), 16, 0, 0); } while (0)
#define PG8_LDA(dst, b, h) do { _Pragma("unroll") for (int m = 0; m < 4; ++m) _Pragma("unroll") for (int k = 0; k < 2; ++k) dst[m][k] = *(const PG8_LAS bf16x8*)(lds + PG8_SA(b, h) + aoff + m * 2048 + k * 1024); } while (0)
#define PG8_LDB(dst, b, h) do { _Pragma("unroll") for (int n = 0; n < 2; ++n) _Pragma("unroll") for (int k = 0; k < 2; ++k) dst[n][k] = *(const PG8_LAS bf16x8*)(lds + PG8_SB(b, h) + boff + n * 2048 + k * 1024); } while (0)
#define PG8_MMA(ai, bj, At, Bt) do { __builtin_amdgcn_s_setprio(1); _Pragma("unroll") for (int m = 0; m < 4; ++m) _Pragma("unroll") for (int n = 0; n < 2; ++n) _Pragma("unroll") for (int k = 0; k < 2; ++k) \
        acc[ai][bj][m][n] = __builtin_amdgcn_mfma_f32_16x16x32_bf16(Bt[n][k], At[m][k], acc[ai][bj][m][n], 0, 0, 0); __builtin_amdgcn_s_setprio(0); } while (0)
#define PG8_WAIT_V(n) asm volatile("s_waitcnt vmcnt(" #n ")" ::: "memory")
#define PG8_WAIT_L(n) asm volatile("s_waitcnt lgkmcnt(" #n ")" ::: "memory")
#define PG8_BAR __builtin_amdgcn_s_barrier()
#define PG8_SCHED __builtin_amdgcn_sched_barrier(0)
    Unit cur, nxt; int ui = 0;
    if (!S.next(0, cur)) return;
    f32x4 acc[2][2][4][2];
#pragma unroll
    for (int a = 0; a < 2; ++a)
#pragma unroll
        for (int b = 0; b < 2; ++b)
#pragma unroll
            for (int m = 0; m < 4; ++m)
#pragma unroll
                for (int n = 0; n < 2; ++n) acc[a][b][m][n] = (f32x4){0.f, 0.f, 0.f, 0.f};
    bf16x8 At[4][2], B0[2][2], B1[2][2];
    const char* cA = (const char*)g.A + (size_t)cur.pm * tstep; const char* cB = (const char*)g.Bt + (size_t)cur.pn * tstep;
    S.a_ready(cur);
    if constexpr (SP2) {
        PG8_STAGE(PG8_SB(0, 0), cB, voffB); PG8_STAGE(PG8_SB(0, 1), cB + hstep, voffB); PG8_STAGE(PG8_SA(0, 0), cA, voffA); PG8_STAGE(PG8_SA(0, 1), cA + hstep, voffA);
        if (wr == 1) PG8_BAR;
        PG8_WAIT_V(2); PG8_BAR;
        PG8_STAGE(PG8_SB(1, 0), cB + kstep, voffB); PG8_STAGE(PG8_SA(1, 0), cA + kstep, voffA); PG8_STAGE(PG8_SB(1, 1), cB + hstep + kstep, voffB);
        PG8_WAIT_V(6); PG8_BAR;
    } else {
        PG8_STAGE(PG8_SB(0, 0), cB, voffB); PG8_STAGE(PG8_SA(0, 0), cA, voffA); PG8_STAGE(PG8_SB(0, 1), cB + hstep, voffB); PG8_STAGE(PG8_SA(0, 1), cA + hstep, voffA);
        if (wr == 1) PG8_BAR;
        PG8_WAIT_V(4); PG8_BAR;
        PG8_STAGE(PG8_SB(1, 0), cB + kstep, voffB); PG8_STAGE(PG8_SA(1, 0), cA + kstep, voffA); PG8_STAGE(PG8_SB(1, 1), cB + hstep + kstep, voffB);
        PG8_WAIT_V(6); PG8_BAR;
    }
    for (;;) {
        const bool has_next = S.next(ui + 1, nxt);
        const char* nA = has_next ? (const char*)g.A + (size_t)nxt.pm * tstep : cA; const char* nB = has_next ? (const char*)g.Bt + (size_t)nxt.pn * tstep : cB;
        for (int t = 0; t < nt; t += 2) {
            const bool last = (t == nt - 2);
            const char* a1 = cA + (size_t)(t + 1) * kstep;
            const char* a2 = last ? nA : cA + (size_t)(t + 2) * kstep; const char* b2 = last ? nB : cB + (size_t)(t + 2) * kstep;
            const char* a3 = a2 + kstep; const char* b3 = b2 + kstep;
            if (last && has_next) S.a_ready(nxt);
            if constexpr (SP2) {
            PG8_LDB(B0, 0, 0); PG8_LDB(B1, 0, 1); PG8_SCHED; PG8_LDA(At, 0, 0); PG8_STAGE(PG8_SA(1, 1), a1 + hstep, voffA);
            PG8_WAIT_V(8); PG8_WAIT_L(0); PG8_BAR; PG8_MMA(0, 0, At, B0); PG8_MMA(0, 1, At, B1); PG8_BAR; PG8_SCHED;
            PG8_LDA(At, 0, 1); PG8_STAGE(PG8_SB(0, 0), b2, voffB); PG8_STAGE(PG8_SB(0, 1), b2 + hstep, voffB); PG8_STAGE(PG8_SA(0, 0), a2, voffA);
            PG8_WAIT_V(8); PG8_WAIT_L(0); PG8_BAR; PG8_MMA(1, 0, At, B0); PG8_MMA(1, 1, At, B1); PG8_BAR; PG8_SCHED;
            PG8_LDB(B0, 1, 0); PG8_LDB(B1, 1, 1); PG8_SCHED; PG8_LDA(At, 1, 0); PG8_STAGE(PG8_SA(0, 1), a2 + hstep, voffA);
            PG8_WAIT_V(8); PG8_WAIT_L(0); PG8_BAR; PG8_MMA(0, 0, At, B0); PG8_MMA(0, 1, At, B1); PG8_BAR; PG8_SCHED;
            PG8_LDA(At, 1, 1); PG8_STAGE(PG8_SB(1, 0), b3, voffB); PG8_STAGE(PG8_SB(1, 1), b3 + hstep, voffB); PG8_STAGE(PG8_SA(1, 0), a3, voffA);
            PG8_WAIT_V(8); PG8_WAIT_L(0); PG8_BAR; PG8_MMA(1, 0, At, B0); PG8_MMA(1, 1, At, B1); PG8_BAR; PG8_SCHED;
            } else {
            PG8_LDB(B0, 0, 0); PG8_SCHED; PG8_LDA(At, 0, 0); PG8_STAGE(PG8_SA(1, 1), a1 + hstep, voffA);
            PG8_WAIT_L(8); PG8_BAR; PG8_WAIT_L(0); PG8_MMA(0, 0, At, B0); PG8_BAR; PG8_SCHED;
            PG8_LDB(B1, 0, 1); PG8_STAGE(PG8_SB(0, 0), b2, voffB);
            PG8_BAR; PG8_WAIT_L(0); PG8_MMA(0, 1, At, B1); PG8_BAR;
            PG8_LDA(At, 0, 1); PG8_STAGE(PG8_SA(0, 0), a2, voffA);
            PG8_BAR; PG8_WAIT_L(0); PG8_MMA(1, 0, At, B0); PG8_BAR; PG8_SCHED;
            PG8_STAGE(PG8_SB(0, 1), b2 + hstep, voffB);
            PG8_WAIT_V(6); PG8_BAR; PG8_MMA(1, 1, At, B1); PG8_BAR;
            PG8_LDB(B0, 1, 0); PG8_SCHED; PG8_LDA(At, 1, 0); PG8_STAGE(PG8_SA(0, 1), a2 + hstep, voffA);
            PG8_WAIT_L(8); PG8_BAR; PG8_WAIT_L(0); PG8_MMA(0, 0, At, B0); PG8_BAR; PG8_SCHED;
            PG8_LDB(B1, 1, 1); PG8_STAGE(PG8_SB(1, 0), b3, voffB);
            PG8_BAR; PG8_WAIT_L(0); PG8_MMA(0, 1, At, B1); PG8_BAR;
            PG8_LDA(At, 1, 1); PG8_STAGE(PG8_SA(1, 0), a3, voffA);
            PG8_BAR; PG8_WAIT_L(0); PG8_MMA(1, 0, At, B0); PG8_BAR; PG8_SCHED;
            PG8_STAGE(PG8_SB(1, 1), b3 + hstep, voffB);
            PG8_WAIT_V(6); PG8_BAR; PG8_MMA(1, 1, At, B1); PG8_BAR;
            }
        }
        if constexpr (ALIGN_EPI) { if (wr == 0) PG8_BAR; }
        if constexpr (!Epi::AFTER_DRAIN) { E(acc, cur, wr, wc, fr, fq); S.done(cur); }
        if (!has_next) break;
#pragma unroll
        for (int a = 0; a < 2; ++a)
#pragma unroll
            for (int b = 0; b < 2; ++b)
#pragma unroll
                for (int m = 0; m < 4; ++m)
#pragma unroll
                    for (int n = 0; n < 2; ++n) acc[a][b][m][n] = (f32x4){0.f, 0.f, 0.f, 0.f};
        cur = nxt; cA = nA; cB = nB; ++ui;
        if constexpr (ALIGN_EPI) { if (wr == 1) PG8_BAR; }
    }
    PG8_WAIT_V(0);
    if constexpr (!ALIGN_EPI) { if (wr == 0) PG8_BAR; }
    PG8_BAR;
    if constexpr (Epi::AFTER_DRAIN) { E.fused(acc, cur, wr, wc, fr, fq, lds, wid, lane); S.done(cur); }
#undef PG8_SA
#undef PG8_SB
#undef PG8_STAGE
#undef PG8_LDA
#undef PG8_LDB
#undef PG8_MMA
#undef PG8_WAIT_V
#undef PG8_WAIT_L
#undef PG8_BAR
#undef PG8_SCHED
}
}

#define LDS_WAIT() asm volatile("s_waitcnt lgkmcnt(0)" ::: "memory")

enum { I_XP = 0, I_XS, I_CK, I_CV, I_MLC, I_MLN, I_MLM, I_RWS, I_C, I_CCTX, I_WMOD, I_BMOD, I_WIN, I_HYCONV, I_HYW1, I_HYB1, I_HYFREQ, I_HYW2, I_HYB2, I_HYW3,
       I_HYBIAS, I_MLGB, I_MLNG, I_RWMU, I_RWW0, I_RWW2, I_RWA0, I_RWA2, I_RWG2, I_RWKK, I_RWKA, I_RWRK, I_RWLNG, I_RWLNB, I_ATQN, I_ATKN, I_WOUT, I_LN1G, I_LN1B,
       I_W1, I_W2, I_LN2G, I_LN2B };
constexpr size_t O_YP = 0, O_YS = 8388608, O_AK = 16777216, O_AV = O_AK + 4194304, O_MC = O_AV + 4194304, O_MN = O_MC + 4194304, O_MM = O_MN + 65536, O_RS = O_MM + 1024;

__device__ __forceinline__ void wconv_wave(const float* __restrict__ W, int K, int N, int Npad, bf16* WT, int item, float* scr, int lane) {
    const int nblk = Npad / 32, kb = item / nblk, nb = item % nblk, k0 = 64 * kb, n0 = 32 * nb;
    const int n = n0 + (lane & 31);
#pragma unroll 8
    for (int i = 0; i < 32; ++i) { const int kk = 2 * i + (lane >> 5); scr[kk * 33 + (lane & 31)] = (n < N) ? W[(size_t)(k0 + kk) * N + n] : 0.f; }
    LDS_WAIT();
    const int c = lane & 7;
#pragma unroll
    for (int j = 0; j < 4; ++j) { const int nn = (lane >> 3) + 8 * j; const float* s = scr + (8 * c) * 33 + nn;
        u32x4 o; o.x = pk2(s[0 * 33], s[1 * 33]); o.y = pk2(s[2 * 33], s[3 * 33]); o.z = pk2(s[4 * 33], s[5 * 33]); o.w = pk2(s[6 * 33], s[7 * 33]);
        *(u32x4*)(WT + (size_t)(n0 + nn) * K + k0 + 8 * c) = o; }
    LDS_WAIT();
}
__device__ __forceinline__ void wconv_block(const float* W, int K, int N, int Npad, bf16* WT, int it0, int cnt, unsigned char* lds, int wave, int lane) {
    float* scr = (float*)lds + wave * (64 * 33);
    for (int i = wave; i < cnt; i += NWAVE) wconv_wave(W, K, N, Npad, WT, it0 + i, scr, lane);
}

__device__ __forceinline__ void phase0(const KA& A, unsigned char* lds, int tid, int wave, int lane, int bid, int G) {
    unsigned char* ws = A.ws;
    {
        const int nitems = (1024 / 64) * (PINP / 32);
        float* scr = (float*)lds + wave * (64 * 33);
        for (int it = bid * NWAVE + wave; it < nitems; it += G * NWAVE) wconv_wave(A.in(I_WIN), 1024, PIN, PINP, (bf16*)(ws + WS_WIN), it, scr, lane);
    }
    __syncthreads();
    {
        float* sil = (float*)lds;
        float* red = sil + 3 * 1024;
        for (int i = tid; i < 3 * 1024; i += NTHR) { const float c = (i < 1024) ? A.in(I_CCTX)[i] : A.in(I_C)[i - 1024]; sil[i] = c / (1.0f + __expf(-c)); }
        __syncthreads();
        for (int item = bid; item < 4 * 96; item += G) {
            const int l = item / 96, cb = item % 96, col = cb * 64 + lane;
            const float* W = A.in(I_WMOD) + (size_t)l * 1024 * 6144 + col;
            float a0 = 0.f, a1 = 0.f, a2 = 0.f;
            const int kbeg = wave * 128;
#pragma unroll 8
            for (int k = kbeg; k < kbeg + 128; ++k) { const float w = W[(size_t)k * 6144]; a0 += sil[k] * w; a1 += sil[1024 + k] * w; a2 += sil[2048 + k] * w; }
            red[(wave * 3 + 0) * 64 + lane] = a0; red[(wave * 3 + 1) * 64 + lane] = a1; red[(wave * 3 + 2) * 64 + lane] = a2;
            __syncthreads();
            if (tid < 192) { const int c = tid >> 6, ln = tid & 63; float s = 0.f;
#pragma unroll
                for (int w = 0; w < 8; ++w) s += red[(w * 3 + c) * 64 + ln];
                ((float*)(ws + WS_MOD))[(size_t)(l * 3 + c) * 6144 + cb * 64 + ln] = s + A.in(I_BMOD)[l * 6144 + cb * 64 + ln]; }
            __syncthreads();
        }
    }
    if (bid == G - 1) {
        float* rt = (float*)(ws + WS_ROPE);
        for (int i = tid; i < 1024; i += NTHR) { const int pos = i >> 4, f = i & 15; const float inv = exp2f(-(float)f * (13.287712379549449f / 16.0f)), ang = (float)pos * inv;
            rt[i] = cosf(ang); rt[1024 + i] = sinf(ang); }
    }
}

__device__ __forceinline__ int cond_of_row(int m) { return m < NCTX ? 0 : 1 + ((m - NCTX) >> 12); }
__device__ __forceinline__ void phase_mod0(const KA& A, int wave, int lane, int bid, int G) {
    const float* mod = (const float*)(A.ws + WS_MOD);
    bf16* H = (bf16*)(A.ws + WS_H);
    for (int m = bid * NWAVE + wave; m < NTOK; m += G * NWAVE) {
        const float* x = (m < NCTX) ? A.in(I_XP) + (size_t)m * 1024 : A.in(I_XS) + (size_t)(m - NCTX) * 1024;
        const float* md = mod + (size_t)cond_of_row(m) * 6144;
#pragma unroll
        for (int j = 0; j < 4; ++j) { const int c = lane * 4 + 256 * j; const f32x4 v = *(const f32x4*)(x + c), sh = *(const f32x4*)(md + c), sc = *(const f32x4*)(md + 1024 + c);
            const f32x4 h = v * (sc + 1.0f) + sh; u32x2 o; o.x = pk2(h[0], h[1]); o.y = pk2(h[2], h[3]); *(u32x2*)(H + (size_t)m * 1024 + c) = o; }
    }
}
__device__ __forceinline__ void phase_ln(const KA& A, const float* g, const float* b, const float* mdn, int shofs, int wave, int lane, int bid, int G) {
    float* X = A.out; bf16* H = (bf16*)(A.ws + WS_H);
    for (int m = bid * NWAVE + wave; m < NTOK; m += G * NWAVE) {
        float* x = X + (size_t)m * 1024;
        f32x4 v[4]; float s = 0.f;
#pragma unroll
        for (int j = 0; j < 4; ++j) { v[j] = *(const f32x4*)(x + lane * 4 + 256 * j); s += (v[j][0] + v[j][1]) + (v[j][2] + v[j][3]); }
        const float mean = wave_sum(s) * (1.f / 1024.f); float q = 0.f;
#pragma unroll
        for (int j = 0; j < 4; ++j) { v[j] = v[j] - mean; q += (v[j][0] * v[j][0] + v[j][1] * v[j][1]) + (v[j][2] * v[j][2] + v[j][3] * v[j][3]); }
        const float rstd = 1.0f / sqrtf(wave_sum(q) * (1.f / 1024.f) + 1e-5f);
        const float* md = mdn ? mdn + (size_t)cond_of_row(m) * 6144 + shofs : nullptr;
#pragma unroll
        for (int j = 0; j < 4; ++j) { const int c = lane * 4 + 256 * j; const f32x4 y = v[j] * rstd * *(const f32x4*)(g + c) + *(const f32x4*)(b + c);
            *(f32x4*)(x + c) = y;
            if (md) { const f32x4 h = y * (*(const f32x4*)(md + 1024 + c) + 1.0f) + *(const f32x4*)(md + c); u32x2 o; o.x = pk2(h[0], h[1]); o.y = pk2(h[2], h[3]); *(u32x2*)(H + (size_t)m * 1024 + c) = o; } }
    }
}

__device__ __forceinline__ void p2_filter_item(const KA& A, int l, int g, int rb, unsigned char* lds, int tid) {
    const int L = g ? 4096 : 256;
    float* z = (float*)lds;
    float* h1 = z + 64 * 33 + 16;
    float* h2 = h1 + 64 * 64;
    for (int i = tid; i < 64 * 33; i += NTHR) { const int row = i / 33, e = i % 33, idx = rb * 64 + row;
        float v;
        if (e == 0) v = (float)idx / (float)(L - 1);
        else { const int j = (e - 1) & 15; const float band = 1e-4f + (float)j * ((15.0f - 1e-4f) / 15.0f);
            float turns = band * ((float)idx / (float)L); turns -= floorf(turns);
            const float ang = 6.283185307179586f * turns;
            v = (e <= 16) ? cosf(ang) : sinf(ang); }
        z[row * 33 + e] = v; }
    __syncthreads();
    { const int n = tid & 63; const float* w1 = A.in(I_HYW1) + (size_t)l * 33 * 64 + n; const float fr = A.in(I_HYFREQ)[l * 64 + n], b1 = A.in(I_HYB1)[l * 64 + n];
      float w[33];
#pragma unroll
      for (int e = 0; e < 33; ++e) w[e] = w1[e * 64];
      for (int k = 0; k < 8; ++k) { const int row = (tid >> 6) + 8 * k; float s = b1;
#pragma unroll
          for (int e = 0; e < 33; ++e) s += z[row * 33 + e] * w[e];
          h1[row * 64 + n] = sinf(fr * s); } }
    __syncthreads();
    { const int n = tid & 63; const float* w2 = A.in(I_HYW2) + (size_t)l * 64 * 64 + n; const float fr = A.in(I_HYFREQ)[l * 64 + n], b2 = A.in(I_HYB2)[l * 64 + n];
      float w[64];
#pragma unroll
      for (int e = 0; e < 64; ++e) w[e] = w2[e * 64];
      for (int k = 0; k < 8; ++k) { const int row = (tid >> 6) + 8 * k; float s = b2;
#pragma unroll
          for (int e = 0; e < 64; e += 4) { const f32x4 hv = *(const f32x4*)(h1 + row * 64 + e); s += hv[0] * w[e] + hv[1] * w[e + 1] + hv[2] * w[e + 2] + hv[3] * w[e + 3]; }
          h2[row * 64 + n] = sinf(fr * s); } }
    __syncthreads();
    bf16* filt = (bf16*)(A.ws + WS_FILT + (g ? FILT_LAT_OFF : 0));
    float* part = (float*)(A.ws + WS_PART) + (size_t)((g ? 4 : 0) + rb) * 1024;
    const float DMIN = -3.0701134573253940f, DMAX = -15.350567286626970f;
    for (int cc = 0; cc < 2; ++cc) {
        const int col = tid + 512 * cc, f = col >> 9, dir = (col >> 8) & 1, c = col & 255;
        const float* w3 = A.in(I_HYW3) + (size_t)l * 64 * 1024 + col;
        float w[64];
#pragma unroll
        for (int e = 0; e < 64; ++e) w[e] = w3[e * 1024];
        const float delta = fabsf(DMIN + (float)c * ((DMAX - DMIN) / 255.0f));
        bf16* fb = filt + (size_t)(f * 256 + c) * (2 * L);
        float asum = 0.f;
        for (int row = 0; row < 64; ++row) { float s = 0.f;
#pragma unroll
            for (int e = 0; e < 64; e += 4) { const f32x4 hv = *(const f32x4*)(h2 + row * 64 + e); s += hv[0] * w[e] + hv[1] * w[e + 1] + hv[2] * w[e + 2] + hv[3] * w[e + 3]; }
            const int m = rb * 64 + row; const float t = (float)m / (float)(L - 1);
            const float v = s * __expf(-t * delta);
            if (dir == 0) { fb[L + m] = (bf16)f2bf(v); asum += fabsf(v); }
            else if (m >= 1) { fb[L - m] = (bf16)f2bf(v); asum += fabsf(v); }
        }
        if (rb == 0 && dir == 0) fb[0] = 0;
        part[col] = asum;
    }
    __syncthreads();
}

__device__ __forceinline__ void p2_tile_item(const KA& A, int l, int tile, unsigned char* lds, int tid) {
    unsigned char* ws = A.ws;
    const bf16* P = (const bf16*)(ws + WS_P);
    const int m0 = tile * 64, g = m0 >= NCTX, L = g ? 4096 : 256;
    const int seqbase = g ? NCTX + ((m0 - NCTX) & ~4095) : (m0 & ~255), b = g ? (m0 - NCTX) >> 12 : m0 >> 8, t0 = m0 - seqbase;
    bf16* T = (bf16*)lds;
    bf16* VT = T + 64 * 72;
    const int tok = tid >> 3, j8 = tid & 7, m = m0 + tok, t = t0 + tok;
    {
        const bool hp = t > 0, hn = t < L - 1;
        bf16* XT = (bf16*)(ws + WS_XT);
        for (int cb = 0; cb < 12; ++cb) {
            const int col = cb * 64 + j8 * 8;
            const bf16* pr = P + (size_t)m * PINP + col;
            const u32x4 cur = *(const u32x4*)pr;
            u32x4 prv = (u32x4){0, 0, 0, 0}, nxt = (u32x4){0, 0, 0, 0};
            if (hp) prv = *(const u32x4*)(pr - PINP);
            if (hn) nxt = *(const u32x4*)(pr + PINP);
            float a[8], bq[8], c[8]; unpack8(prv, a); unpack8(cur, bq); unpack8(nxt, c);
            const float* cw = A.in(I_HYCONV) + (size_t)l * 3 * 768 + col;
#pragma unroll
            for (int e = 0; e < 8; ++e) { const float o = a[e] * cw[e] + bq[e] * cw[768 + e] + c[e] * cw[1536 + e]; T[(j8 * 8 + e) * 72 + tok] = (bf16)f2bf(o); }
            __syncthreads();
            { const int colr = tid >> 3, tg = tid & 7; const u32x4 v = *(const u32x4*)(T + colr * 72 + tg * 8);
              const int which = cb >> 2, ch = (cb & 3) * 64 + colr;
              *(u32x4*)(XT + ((size_t)which * 256 + ch) * NTOK + m0 + tg * 8) = v; }
            __syncthreads();
        }
    }
    {
        const float* rt = (const float*)(ws + WS_ROPE);
        if (j8 < 6) {
            const int col = C_AT + j8 * 64;
            float x[64];
#pragma unroll
            for (int e = 0; e < 8; ++e) { const u32x4 w = *(const u32x4*)(P + (size_t)m * PINP + col + e * 8); unpack8(w, x + e * 8); }
            float ss = 0.f;
#pragma unroll
            for (int e = 0; e < 64; ++e) ss += x[e] * x[e];
            const float r = 1.0f / sqrtf(ss * (1.f / 64.f) + 1e-6f);
            const float* wn = (j8 < 4 ? A.in(I_ATQN) : A.in(I_ATKN)) + l * 64;
#pragma unroll
            for (int e = 0; e < 64; ++e) x[e] = x[e] * r * wn[e];
            if (g) {
                const int prow = t >> 6, pcol = t & 63;
#pragma unroll
                for (int i = 0; i < 16; ++i) {
                    const float c1 = rt[prow * 16 + i], s1 = rt[1024 + prow * 16 + i], c2 = rt[pcol * 16 + i], s2 = rt[1024 + pcol * 16 + i];
                    const float a1 = x[i], b1 = x[16 + i], a2 = x[32 + i], b2 = x[48 + i];
                    x[i] = a1 * c1 - b1 * s1; x[16 + i] = a1 * s1 + b1 * c1; x[32 + i] = a2 * c2 - b2 * s2; x[48 + i] = a2 * s2 + b2 * c2; }
            }
            if (j8 < 4) {
                bf16* q = (bf16*)(ws + WS_QB) + (size_t)m * 256 + j8 * 64;
#pragma unroll
                for (int e = 0; e < 8; ++e) { u32x4 o; o.x = pk2(x[e * 8] * QSCALE, x[e * 8 + 1] * QSCALE); o.y = pk2(x[e * 8 + 2] * QSCALE, x[e * 8 + 3] * QSCALE);
                    o.z = pk2(x[e * 8 + 4] * QSCALE, x[e * 8 + 5] * QSCALE); o.w = pk2(x[e * 8 + 6] * QSCALE, x[e * 8 + 7] * QSCALE); *(u32x4*)(q + e * 8) = o; }
            } else {
                const int kvh = j8 - 4;
                bf16* kd = g ? (bf16*)(ws + WS_KBL) + ((size_t)(b * 2 + kvh) * 4608 + t) * 64 : (bf16*)(ws + WS_KBC) + ((size_t)(b * 2 + kvh) * 256 + t) * 64;
#pragma unroll
                for (int e = 0; e < 8; ++e) { u32x4 o; o.x = pk2(x[e * 8], x[e * 8 + 1]); o.y = pk2(x[e * 8 + 2], x[e * 8 + 3]); o.z = pk2(x[e * 8 + 4], x[e * 8 + 5]); o.w = pk2(x[e * 8 + 6], x[e * 8 + 7]);
                    *(u32x4*)(kd + e * 8) = o; }
                if (!g) { float* ok = A.out + O_AK + ((((size_t)b * 4 + l) * 256 + t) * 2 + kvh) * 64;
#pragma unroll
                    for (int e = 0; e < 16; ++e) *(f32x4*)(ok + e * 4) = (f32x4){x[e * 4], x[e * 4 + 1], x[e * 4 + 2], x[e * 4 + 3]}; }
            }
        } else {
            const int kvh = j8 - 6, col = C_AT + 384 + kvh * 64;
            float x[64];
#pragma unroll
            for (int e = 0; e < 8; ++e) { const u32x4 w = *(const u32x4*)(P + (size_t)m * PINP + col + e * 8); unpack8(w, x + e * 8); }
            if (!g) { float* ov = A.out + O_AV + ((((size_t)b * 4 + l) * 256 + t) * 2 + kvh) * 64;
#pragma unroll
                for (int e = 0; e < 16; ++e) *(f32x4*)(ov + e * 4) = (f32x4){x[e * 4], x[e * 4 + 1], x[e * 4 + 2], x[e * 4 + 3]}; }
#pragma unroll
            for (int e = 0; e < 64; ++e) VT[(kvh * 64 + e) * 72 + tok] = (bf16)f2bf(x[e]);
        }
        __syncthreads();
        for (int i = tid; i < 1024; i += NTHR) { const int row = i >> 3, tg = i & 7, kvh = row >> 6, d = row & 63;
            const u32x4 v = *(const u32x4*)(VT + row * 72 + tg * 8);
            bf16* vd = g ? (bf16*)(ws + WS_VTL) + ((size_t)(b * 2 + kvh) * 64 + d) * 4608 + t0 + tg * 8 : (bf16*)(ws + WS_VTC) + ((size_t)(b * 2 + kvh) * 64 + d) * 256 + t0 + tg * 8;
            *(u32x4*)vd = v; }
        __syncthreads();
    }
}
__device__ __forceinline__ void p2_cache_item(const KA& A, int l, int item, int tid) {
    const int b = item >> 1, kvh = item & 1;
    const float* ck = A.in(I_CK) + ((size_t)(b * 4 + l) * 512) * 128 + kvh * 64;
    const float* cv = A.in(I_CV) + ((size_t)(b * 4 + l) * 512) * 128 + kvh * 64;
    bf16* kd = (bf16*)(A.ws + WS_KBL) + ((size_t)(b * 2 + kvh) * 4608 + 4096) * 64;
    bf16* vd = (bf16*)(A.ws + WS_VTL) + ((size_t)(b * 2 + kvh) * 64) * 4608 + 4096;
    for (int i = tid; i < 512 * 64; i += NTHR) { const int s = i >> 6, d = i & 63;
        kd[s * 64 + d] = (bf16)f2bf(ck[(size_t)s * 128 + d]);
        vd[(size_t)d * 4608 + s] = (bf16)f2bf(cv[(size_t)s * 128 + d]); }
}
__device__ __forceinline__ void phase2(const KA& A, int l, unsigned char* lds, int tid0, int bid, int G) {
    for (int it = bid; it < 68 + 256 + 4; it += G) {
        int tid = tid0; asm volatile("" : "+v"(tid));
        if (it < 64) p2_filter_item(A, l, 1, it, lds, tid);
        else if (it < 68) p2_filter_item(A, l, 0, it - 64, lds, tid);
        else if (it < 68 + 256) p2_tile_item(A, l, it - 68, lds, tid);
        else p2_cache_item(A, l, it - 68 - 256, tid);
        __syncthreads();
    }
}

#define HY_STEP(NEW, OLD, SS) do { \
    const int B16_ = L + t0 - (SS) - 16; const float* kp_ = KT + B16_ + (B16_ >> 4); \
    _Pragma("unroll") for (int n = 0; n < 15; ++n) NEW[n] = kp_[1 + n]; \
    NEW[15] = kp_[17]; \
    const f32x4 q0_ = *(const f32x4*)(Vb + (SS)), q1_ = *(const f32x4*)(Vb + (SS) + 4), q2_ = *(const f32x4*)(Vb + (SS) + 8), q3_ = *(const f32x4*)(Vb + (SS) + 12); \
    const float vv_[16] = {q0_[0], q0_[1], q0_[2], q0_[3], q1_[0], q1_[1], q1_[2], q1_[3], q2_[0], q2_[1], q2_[2], q2_[3], q3_[0], q3_[1], q3_[2], q3_[3]}; \
    _Pragma("unroll") for (int jj = 0; jj < 16; ++jj) \
    _Pragma("unroll") for (int i = 0; i < 16; ++i) { const int n = 15 + i - jj; y[i] += (n < 16 ? NEW[n < 16 ? n : 0] : OLD[n >= 16 ? n - 16 : 0]) * vv_[jj]; } \
} while (0)

__device__ __forceinline__ void hy_conv_pass(const float* KT, const float* Vb, int L, int t0, float (&y)[16]) {
    float wa[16], wb[16];
    { const int B16 = L + t0; const float* kp = KT + B16 + (B16 >> 4);
#pragma unroll
      for (int j = 0; j < 15; ++j) wb[j] = kp[1 + j];
      wb[15] = 0.f; }
#pragma unroll
    for (int i = 0; i < 16; ++i) y[i] = 0.f;
    for (int S = 0; S < L; S += 32) { HY_STEP(wa, wb, S); HY_STEP(wb, wa, S + 16); }
}
__device__ __forceinline__ void hy_load_taps(const bf16* frow, float* KT, int L, int tid) {
    for (int i = tid * 8; i < 2 * L; i += NTHR * 8) { const u32x4 w = *(const u32x4*)(frow + i); float f[8]; unpack8(w, f); float* d = KT + i + (i >> 4);
#pragma unroll
        for (int e = 0; e < 8; ++e) d[e] = f[e]; }
}
__device__ __forceinline__ void hy_unit(const KA& A, int l, int g, int c, unsigned char* lds, int tid, int lane, int wave) {
    const int L = g ? 4096 : 256, mb = g ? NCTX : 0;
    float* KT = (float*)lds;
    float* V = KT + 8704;
    float* Z = V + 8192;
    float* nrm = Z + 8192;
    const bf16* filt = (const bf16*)(A.ws + WS_FILT + (g ? FILT_LAT_OFF : 0));
    bf16* XT = (bf16*)(A.ws + WS_XT);
    bf16* vT = XT + (size_t)c * NTOK + mb; const bf16* x1T = XT + ((size_t)256 + c) * NTOK + mb; const bf16* x2T = XT + ((size_t)512 + c) * NTOK + mb;
    hy_load_taps(filt + (size_t)c * (2 * L), KT, L, tid);
    for (int i = tid * 8; i < 8192; i += NTHR * 8) { const u32x4 w = *(const u32x4*)(vT + i); float f[8]; unpack8(w, f);
        *(f32x4*)(V + i) = (f32x4){f[0], f[1], f[2], f[3]}; *(f32x4*)(V + i + 4) = (f32x4){f[4], f[5], f[6], f[7]}; }
    if (wave < 2) { const float* part = (const float*)(A.ws + WS_PART) + (size_t)(g ? 4 : 0) * 1024; const int nrb = g ? 64 : 4;
        float p = 0.f; if (lane < nrb) p = part[(size_t)lane * 1024 + wave * 512 + c] + part[(size_t)lane * 1024 + wave * 512 + 256 + c];
        p = wave_sum(p); if (lane == 0) nrm[wave] = p; }
    __syncthreads();
    const int o0 = tid * 16, bq = o0 / L, t0 = o0 - bq * L;
    float y[16];
    hy_conv_pass(KT, V + bq * L, L, t0, y);
    {
        const float inv = 1.0f / nrm[0], bias = A.in(I_HYBIAS)[l * 512 + c];
        float x1[16]; { const u32x4 w0 = *(const u32x4*)(x1T + o0), w1 = *(const u32x4*)(x1T + o0 + 8); unpack8(w0, x1); unpack8(w1, x1 + 8); }
#pragma unroll
        for (int i = 0; i < 16; ++i) { const float v = V[o0 + i]; Z[o0 + i] = x1[i] * (y[i] * inv + v * bias); }
    }
    __syncthreads();
    hy_load_taps(filt + (size_t)(256 + c) * (2 * L), KT, L, tid);
    __syncthreads();
    hy_conv_pass(KT, Z + bq * L, L, t0, y);
    {
        const float inv = 1.0f / nrm[1], bias = A.in(I_HYBIAS)[l * 512 + 256 + c];
        float x2[16]; { const u32x4 w0 = *(const u32x4*)(x2T + o0), w1 = *(const u32x4*)(x2T + o0 + 8); unpack8(w0, x2); unpack8(w1, x2 + 8); }
        float o[16];
#pragma unroll
        for (int i = 0; i < 16; ++i) { const float z = Z[o0 + i]; o[i] = x2[i] * (y[i] * inv + z * bias); }
        u32x4 w0, w1; w0.x = pk2(o[0], o[1]); w0.y = pk2(o[2], o[3]); w0.z = pk2(o[4], o[5]); w0.w = pk2(o[6], o[7]);
        w1.x = pk2(o[8], o[9]); w1.y = pk2(o[10], o[11]); w1.z = pk2(o[12], o[13]); w1.w = pk2(o[14], o[15]);
        *(u32x4*)(vT + o0) = w0; *(u32x4*)(vT + o0 + 8) = w1;
    }
    __syncthreads();
}

__device__ __forceinline__ int crow(int r, int hi) { return (r & 3) + 8 * (r >> 2) + 4 * hi; }
__device__ __forceinline__ void attn_unit(const KA& A, int g, int b, int kvh, int qt, unsigned char* lds, int tid, int lane, int wave) {
    unsigned char* ws = A.ws;
    const int NK = g ? 4608 : 256, NT = NK / 64;
    const bf16* Kg = g ? (const bf16*)(ws + WS_KBL) + (size_t)(b * 2 + kvh) * 4608 * 64 : (const bf16*)(ws + WS_KBC) + (size_t)(b * 2 + kvh) * 256 * 64;
    const bf16* Vg = g ? (const bf16*)(ws + WS_VTL) + (size_t)(b * 2 + kvh) * 64 * 4608 : (const bf16*)(ws + WS_VTC) + (size_t)(b * 2 + kvh) * 64 * 256;
    const int mrow0 = (g ? NCTX + b * 4096 : b * 256) + qt * 128;
    const int hh = wave & 1, tb = wave >> 1, head = kvh * 2 + hh, r32 = lane & 31, hi = lane >> 5;
    unsigned char* Kl = lds;
    unsigned char* Vl = lds + 2 * 9216;
    bf16x8 qf[4];
    { const bf16* q = (const bf16*)(ws + WS_QB) + (size_t)(mrow0 + tb * 32 + r32) * 256 + head * 64 + hi * 8;
#pragma unroll
      for (int s = 0; s < 4; ++s) qf[s] = *(const bf16x8*)(q + s * 16); }
    const int lrow = tid >> 3, lch = tid & 7;
    u32x4 kreg, vreg;
    kreg = *(const u32x4*)(Kg + (size_t)lrow * 64 + lch * 8);
    vreg = *(const u32x4*)(Vg + (size_t)lrow * NK + lch * 8);
    *(u32x4*)(Kl + lrow * 144 + lch * 16) = kreg;
    *(u32x2*)(Vl + lrow * 136 + lch * 16) = (u32x2){vreg.x, vreg.y}; *(u32x2*)(Vl + lrow * 136 + lch * 16 + 8) = (u32x2){vreg.z, vreg.w};
    __syncthreads();
    f32x16 o0 = {}, o1 = {};
    float mrun = -1e30f, lsum = 0.f;
    for (int j = 0; j < NT; ++j) {
        const int cur = j & 1;
        if (j + 1 < NT) { kreg = *(const u32x4*)(Kg + (size_t)((j + 1) * 64 + lrow) * 64 + lch * 8); vreg = *(const u32x4*)(Vg + (size_t)lrow * NK + (j + 1) * 64 + lch * 8); }
        const unsigned char* Kc = Kl + cur * 9216; const unsigned char* Vc = Vl + cur * 8704;
        f32x16 s0 = {}, s1 = {};
#pragma unroll
        for (int s = 0; s < 4; ++s) {
            const bf16x8 k0 = *(const bf16x8*)(Kc + r32 * 144 + s * 32 + hi * 16);
            const bf16x8 k1 = *(const bf16x8*)(Kc + (32 + r32) * 144 + s * 32 + hi * 16);
            s0 = __builtin_amdgcn_mfma_f32_32x32x16_bf16(k0, qf[s], s0, 0, 0, 0);
            s1 = __builtin_amdgcn_mfma_f32_32x32x16_bf16(k1, qf[s], s1, 0, 0, 0);
        }
        float tm = fmaxf(s0[0], s1[0]);
#pragma unroll
        for (int r = 1; r < 16; ++r) tm = fmaxf(tm, fmaxf(s0[r], s1[r]));
        tm = fmaxf(tm, __shfl_xor(tm, 32));
        const float mnew = fmaxf(mrun, tm), alpha = __builtin_amdgcn_exp2f(mrun - mnew);
        mrun = mnew;
        float ps = 0.f;
#pragma unroll
        for (int r = 0; r < 16; ++r) { s0[r] = __builtin_amdgcn_exp2f(s0[r] - mnew); s1[r] = __builtin_amdgcn_exp2f(s1[r] - mnew); ps += s0[r] + s1[r]; }
        lsum = lsum * alpha + ps;
#pragma unroll
        for (int r = 0; r < 16; ++r) { o0[r] *= alpha; o1[r] *= alpha; }
#pragma unroll
        for (int ks = 0; ks < 4; ++ks) {
            bf16x8 pf;
            { u32x4 w; const int rb = 8 * (ks & 1);
              if (ks < 2) { w.x = pk2(s0[rb], s0[rb + 1]); w.y = pk2(s0[rb + 2], s0[rb + 3]); w.z = pk2(s0[rb + 4], s0[rb + 5]); w.w = pk2(s0[rb + 6], s0[rb + 7]); }
              else        { w.x = pk2(s1[rb], s1[rb + 1]); w.y = pk2(s1[rb + 2], s1[rb + 3]); w.z = pk2(s1[rb + 4], s1[rb + 5]); w.w = pk2(s1[rb + 6], s1[rb + 7]); }
              pf = __builtin_bit_cast(bf16x8, w); }
            const int kb = (16 * ks + 4 * hi) * 2;
            { const u32x2 a = *(const u32x2*)(Vc + r32 * 136 + kb), bq = *(const u32x2*)(Vc + r32 * 136 + kb + 16);
              const bf16x8 vf = __builtin_bit_cast(bf16x8, (u32x4){a.x, a.y, bq.x, bq.y});
              o0 = __builtin_amdgcn_mfma_f32_32x32x16_bf16(vf, pf, o0, 0, 0, 0); }
            { const u32x2 a = *(const u32x2*)(Vc + (32 + r32) * 136 + kb), bq = *(const u32x2*)(Vc + (32 + r32) * 136 + kb + 16);
              const bf16x8 vf = __builtin_bit_cast(bf16x8, (u32x4){a.x, a.y, bq.x, bq.y});
              o1 = __builtin_amdgcn_mfma_f32_32x32x16_bf16(vf, pf, o1, 0, 0, 0); }
        }
        if (j + 1 < NT) { unsigned char* Kn = Kl + (cur ^ 1) * 9216; unsigned char* Vn = Vl + (cur ^ 1) * 8704;
            *(u32x4*)(Kn + lrow * 144 + lch * 16) = kreg;
            *(u32x2*)(Vn + lrow * 136 + lch * 16) = (u32x2){vreg.x, vreg.y}; *(u32x2*)(Vn + lrow * 136 + lch * 16 + 8) = (u32x2){vreg.z, vreg.w}; }
        __syncthreads();
    }
    lsum += __shfl_xor(lsum, 32);
    const float inv = 1.0f / lsum;
    bf16* yo = (bf16*)(ws + WS_YC) + (size_t)(mrow0 + tb * 32 + r32) * 1024 + 768 + head * 64;
#pragma unroll
    for (int rg = 0; rg < 4; ++rg) { const int d = 8 * rg + 4 * hi;
        u32x2 w; w.x = pk2(o0[4 * rg] * inv, o0[4 * rg + 1] * inv); w.y = pk2(o0[4 * rg + 2] * inv, o0[4 * rg + 3] * inv); *(u32x2*)(yo + d) = w;
        u32x2 w2; w2.x = pk2(o1[4 * rg] * inv, o1[4 * rg + 1] * inv); w2.y = pk2(o1[4 * rg + 2] * inv, o1[4 * rg + 3] * inv); *(u32x2*)(yo + 32 + d) = w2; }
}

struct ChunkItem { int g, b, h, dir, c, L, nc, seqbase; };
__device__ __forceinline__ ChunkItem decode_item(int it) {
    ChunkItem x;
    if (it < 512) { const int ch = it >> 1; x.g = 0; x.c = it & 1; x.b = ch >> 3; x.h = (ch >> 1) & 3; x.dir = ch & 1; x.L = 256; x.nc = 2; x.seqbase = x.b * 256; }
    else { const int i2 = it - 512, ch = i2 >> 5; x.g = 1; x.c = i2 & 31; x.b = ch >> 3; x.h = (ch >> 1) & 3; x.dir = ch & 1; x.L = 4096; x.nc = 32; x.seqbase = NCTX + x.b * 4096; }
    return x;
}
__device__ __forceinline__ int item_of(int g, int b, int h, int dir, int c) { const int ch = (b * 4 + h) * 2 + dir; return g ? 512 + ch * 32 + c : ch * 2 + c; }

__device__ __forceinline__ void ml_scan128(const float* li, const float* lf, float* bcum, float* av, float* pm, int lane) {
    const float x0 = lf[2 * lane], x1 = lf[2 * lane + 1];
    float s = x0 + x1;
#pragma unroll
    for (int o = 1; o < 64; o <<= 1) { const float t = __shfl_up(s, o); if (lane >= o) s += t; }
    const float ex = s - (x0 + x1);
    const float b0 = ex + x0, b1 = ex + x0 + x1;
    const float a0 = li[2 * lane] - b0, a1 = li[2 * lane + 1] - b1;
    float mx = fmaxf(a0, a1);
#pragma unroll
    for (int o = 1; o < 64; o <<= 1) { const float t = __shfl_up(mx, o); if (lane >= o) mx = fmaxf(mx, t); }
    float pe = __shfl_up(mx, 1); if (lane == 0) pe = -INFINITY;
    bcum[2 * lane] = b0; bcum[2 * lane + 1] = b1; av[2 * lane] = a0; av[2 * lane + 1] = a1;
    pm[2 * lane] = fmaxf(pe, a0); pm[2 * lane + 1] = fmaxf(pe, fmaxf(a0, a1));
}
__device__ __forceinline__ void ml_load_gates(const KA& A, int l, const ChunkItem& x, float* li, float* lf, int tid) {
    if (tid < 128) { const int tk = x.dir ? x.L - 1 - (x.c * 128 + tid) : x.c * 128 + tid; const bf16* p = (const bf16*)(A.ws + WS_P) + (size_t)(x.seqbase + tk) * PINP + C_MLG + x.dir * 8 + x.h;
        const float* gb = A.in(I_MLGB) + l * 16 + x.dir * 8 + x.h;
        li[tid] = bf2f(p[0]) + gb[0]; lf[tid] = logsigmoidf_(bf2f(p[4]) + gb[4]); }
}

__device__ __forceinline__ void ml_local_item(const KA& A, int l, int it, unsigned char* lds, int tid, int lane, int wave) {
    const ChunkItem x = decode_item(it);
    float* kf = (float*)lds;
    float* vf = kf + 128 * 64;
    float* li = vf + 128 * 64; float* lf = li + 128; float* bc = lf + 128; float* av = bc + 128; float* pm = av + 128; float* wk = pm + 128;
    const bf16* P = (const bf16*)(A.ws + WS_P);
    { const int row = tid >> 2, q4 = tid & 3; const int tk = x.dir ? x.L - 1 - (x.c * 128 + row) : x.c * 128 + row;
      const bf16* pr = P + (size_t)(x.seqbase + tk) * PINP + C_ML + x.h * 64 + q4 * 16;
      float f[8];
      unpack8(*(const u32x4*)(pr + 256), f); *(f32x4*)(kf + row * 64 + q4 * 16) = (f32x4){f[0], f[1], f[2], f[3]}; *(f32x4*)(kf + row * 64 + q4 * 16 + 4) = (f32x4){f[4], f[5], f[6], f[7]};
      unpack8(*(const u32x4*)(pr + 256 + 8), f); *(f32x4*)(kf + row * 64 + q4 * 16 + 8) = (f32x4){f[0], f[1], f[2], f[3]}; *(f32x4*)(kf + row * 64 + q4 * 16 + 12) = (f32x4){f[4], f[5], f[6], f[7]};
      unpack8(*(const u32x4*)(pr + 512), f); *(f32x4*)(vf + row * 64 + q4 * 16) = (f32x4){f[0], f[1], f[2], f[3]}; *(f32x4*)(vf + row * 64 + q4 * 16 + 4) = (f32x4){f[4], f[5], f[6], f[7]};
      unpack8(*(const u32x4*)(pr + 512 + 8), f); *(f32x4*)(vf + row * 64 + q4 * 16 + 8) = (f32x4){f[0], f[1], f[2], f[3]}; *(f32x4*)(vf + row * 64 + q4 * 16 + 12) = (f32x4){f[4], f[5], f[6], f[7]}; }
    ml_load_gates(A, l, x, li, lf, tid);
    __syncthreads();
    if (wave == 0) ml_scan128(li, lf, bc, av, pm, lane);
    __syncthreads();
    const float pmax = pm[127];
    if (tid < 128) wk[tid] = __expf(av[tid] - pmax);
    __syncthreads();
    const int d = tid >> 3, eg = tid & 7;
    float acc[8] = {0.f, 0.f, 0.f, 0.f, 0.f, 0.f, 0.f, 0.f}, nacc = 0.f;
    for (int s = 0; s < 128; ++s) { const float kw = kf[s * 64 + d] * wk[s]; const f32x4 v0 = *(const f32x4*)(vf + s * 64 + eg * 8), v1 = *(const f32x4*)(vf + s * 64 + eg * 8 + 4);
        nacc += kw;
        acc[0] += kw * v0[0]; acc[1] += kw * v0[1]; acc[2] += kw * v0[2]; acc[3] += kw * v0[3]; acc[4] += kw * v1[0]; acc[5] += kw * v1[1]; acc[6] += kw * v1[2]; acc[7] += kw * v1[3]; }
    float* o = (float*)(A.ws + WS_MLS) + (size_t)it * MLS_STRIDE;
    *(f32x4*)(o + d * 64 + eg * 8) = (f32x4){acc[0], acc[1], acc[2], acc[3]}; *(f32x4*)(o + d * 64 + eg * 8 + 4) = (f32x4){acc[4], acc[5], acc[6], acc[7]};
    if (eg == 0) o[4096 + d] = nacc;
    if (tid == 0) { o[4160] = pmax; o[4161] = bc[127]; }
    __syncthreads();
}

__device__ __forceinline__ void ml_scan_chain(const KA& A, int l, int ch, int tid) {
    const int g = ch >= 256, cl = g ? ch - 256 : ch, b = cl >> 3, h = (cl >> 1) & 3, dir = cl & 1, nc = g ? 32 : 2;
    const size_t sidx = (((size_t)(b * 4 + l) * 2 + dir) * 4 + h);
    float C[8], n = 0.f, m = 0.f;
#pragma unroll
    for (int e = 0; e < 8; ++e) C[e] = 0.f;
    if (g) { const float* c0 = A.in(I_MLC) + sidx * 4096 + tid * 8;
#pragma unroll
        for (int e = 0; e < 8; ++e) C[e] = c0[e];
        if (tid < 64) n = A.in(I_MLN)[sidx * 64 + tid];
        m = A.in(I_MLM)[sidx]; }
    for (int c = 0; c < nc; ++c) {
        float* o = (float*)(A.ws + WS_MLS) + (size_t)item_of(g, b, h, dir, c) * MLS_STRIDE;
        float cl8[8];
#pragma unroll
        for (int e = 0; e < 8; ++e) cl8[e] = o[tid * 8 + e];
        const float nl = tid < 64 ? o[4096 + tid] : 0.f, pmax = o[4160], bl = o[4161];
        __syncthreads();
#pragma unroll
        for (int e = 0; e < 8; ++e) o[tid * 8 + e] = C[e];
        if (tid < 64) o[4096 + tid] = n;
        if (tid == 0) o[4162] = m;
        const float Mx = fmaxf(m, pmax), dec = __expf(m - Mx), sc = __expf(pmax - Mx);
#pragma unroll
        for (int e = 0; e < 8; ++e) C[e] = dec * C[e] + sc * cl8[e];
        n = dec * n + sc * nl; m = bl + Mx;
    }
    if (!g) { float* oc = A.out + O_MC + sidx * 4096 + tid * 8;
#pragma unroll
        for (int e = 0; e < 8; ++e) oc[e] = C[e];
        if (tid < 64) A.out[O_MN + sidx * 64 + tid] = n;
        if (tid == 0) A.out[O_MM + sidx] = m; }
}

__device__ __forceinline__ void ml_out_item(const KA& A, int l, int item, unsigned char* lds, int tid, int lane, int wave) {
    int g, b, h, tc, L, nc, seqbase;
    if (item < 256) { g = 0; tc = item & 1; const int bh = item >> 1; b = bh >> 2; h = bh & 3; L = 256; nc = 2; seqbase = b * 256; }
    else { const int i2 = item - 256; g = 1; tc = i2 & 31; const int bh = i2 >> 5; b = bh >> 2; h = bh & 3; L = 4096; nc = 32; seqbase = NCTX + b * 4096; }
    bf16* qs = (bf16*)lds;
    bf16* ks = qs + 128 * 72;
    bf16* vs = ks + 128 * 72;
    float* S = (float*)(vs + 128 * 72);
    float* Cs = S + 128 * 132;
    float* nv = Cs + 4096;
    float* li = nv + 64; float* lf = li + 128; float* bc = lf + 128; float* av = bc + 128; float* pm = av + 128;
    float* Mv = pm + 128; float* win = Mv + 128; float* flo = win + 128;
    const bf16* P = (const bf16*)(A.ws + WS_P);
    const int jr = tid >> 4, ec = tid & 15;
    float hacc[4][4];
#pragma unroll
    for (int i = 0; i < 4; ++i)
#pragma unroll
        for (int e = 0; e < 4; ++e) hacc[i][e] = 0.f;
    for (int dir = 0; dir < 2; ++dir) {
        ChunkItem x; x.g = g; x.b = b; x.h = h; x.dir = dir; x.c = dir ? nc - 1 - tc : tc; x.L = L; x.nc = nc; x.seqbase = seqbase;
        const float* st = (const float*)(A.ws + WS_MLS) + (size_t)item_of(g, b, h, dir, x.c) * MLS_STRIDE;
        __syncthreads();
        { const int row = tid >> 2, q4 = tid & 3; const int tk = dir ? L - 1 - (x.c * 128 + row) : x.c * 128 + row;
          const bf16* pr = P + (size_t)(seqbase + tk) * PINP + C_ML + h * 64 + q4 * 16;
          u32x4 w0 = *(const u32x4*)pr, w1 = *(const u32x4*)(pr + 8);
          { float f[8]; unpack8(w0, f); w0.x = pk2(f[0] * 0.125f, f[1] * 0.125f); w0.y = pk2(f[2] * 0.125f, f[3] * 0.125f); w0.z = pk2(f[4] * 0.125f, f[5] * 0.125f); w0.w = pk2(f[6] * 0.125f, f[7] * 0.125f);
            unpack8(w1, f); w1.x = pk2(f[0] * 0.125f, f[1] * 0.125f); w1.y = pk2(f[2] * 0.125f, f[3] * 0.125f); w1.z = pk2(f[4] * 0.125f, f[5] * 0.125f); w1.w = pk2(f[6] * 0.125f, f[7] * 0.125f); }
          *(u32x4*)(qs + row * 72 + q4 * 16) = w0; *(u32x4*)(qs + row * 72 + q4 * 16 + 8) = w1;
          *(u32x4*)(ks + row * 72 + q4 * 16) = *(const u32x4*)(pr + 256); *(u32x4*)(ks + row * 72 + q4 * 16 + 8) = *(const u32x4*)(pr + 256 + 8);
          *(u32x4*)(vs + row * 72 + q4 * 16) = *(const u32x4*)(pr + 512); *(u32x4*)(vs + row * 72 + q4 * 16 + 8) = *(const u32x4*)(pr + 512 + 8); }
        for (int i = tid; i < 4096; i += NTHR) Cs[i] = st[i];
        if (tid < 64) nv[tid] = st[4096 + tid];
        ml_load_gates(A, l, x, li, lf, tid);
        __syncthreads();
        if (wave == 0) ml_scan128(li, lf, bc, av, pm, lane);
        __syncthreads();
        const float m_in = st[4162];
        if (tid < 128) { const float Mx = fmaxf(m_in, pm[tid]); Mv[tid] = Mx; win[tid] = __expf(m_in - Mx); flo[tid] = __expf(-(bc[tid] + Mx)); }
        __syncthreads();
        { const int tb = tid >> 4, sb = tid & 15;
          float acc[4][8];
#pragma unroll
          for (int i = 0; i < 4; ++i)
#pragma unroll
              for (int k = 0; k < 8; ++k) acc[i][k] = 0.f;
#pragma unroll 1
          for (int dc = 0; dc < 8; ++dc) {
              float qf[4][8], kf[8];
#pragma unroll
              for (int i = 0; i < 4; ++i) unpack8(*(const u32x4*)(qs + (tb + 32 * i) * 72 + dc * 8), qf[i]);
#pragma unroll
              for (int k = 0; k < 8; ++k) { unpack8(*(const u32x4*)(ks + (sb + 16 * k) * 72 + dc * 8), kf);
#pragma unroll
                  for (int i = 0; i < 4; ++i)
#pragma unroll
                      for (int e = 0; e < 8; ++e) acc[i][k] += qf[i][e] * kf[e]; }
          }
#pragma unroll
          for (int i = 0; i < 4; ++i) { const int t = tb + 32 * i; const float Mx = Mv[t];
#pragma unroll
              for (int k = 0; k < 8; ++k) { const int s = sb + 16 * k; S[t * 132 + s] = (s <= t) ? acc[i][k] * __expf(av[s] - Mx) : 0.f; } }
        }
        __syncthreads();
#pragma unroll 1
        for (int i = 0; i < 4; ++i) {
            const int j = jr + 32 * i, t = dir ? 127 - j : j;
            float num[4] = {0.f, 0.f, 0.f, 0.f}, den = 0.f;
#pragma unroll 2
            for (int s = 0; s < 128; s += 4) { const f32x4 sv = *(const f32x4*)(S + t * 132 + s);
#pragma unroll
                for (int u = 0; u < 4; ++u) { const u32x2 vw = *(const u32x2*)(vs + (s + u) * 72 + ec * 4); const float sc = sv[u];
                    den += sc; num[0] += sc * lo16(vw.x); num[1] += sc * hi16(vw.x); num[2] += sc * lo16(vw.y); num[3] += sc * hi16(vw.y); } }
            float qc[4] = {0.f, 0.f, 0.f, 0.f}, qn = 0.f;
#pragma unroll 1
            for (int d8 = 0; d8 < 8; ++d8) { float qf[8]; unpack8(*(const u32x4*)(qs + t * 72 + d8 * 8), qf);
#pragma unroll
                for (int e = 0; e < 8; ++e) { const f32x4 cv = *(const f32x4*)(Cs + (d8 * 8 + e) * 64 + ec * 4); qc[0] += qf[e] * cv[0]; qc[1] += qf[e] * cv[1]; qc[2] += qf[e] * cv[2]; qc[3] += qf[e] * cv[3]; qn += qf[e] * nv[d8 * 8 + e]; } }
            const float w = win[t]; den += w * qn;
            const float dd = 1.0f / fmaxf(fabsf(den), flo[t]);
#pragma unroll
            for (int e = 0; e < 4; ++e) hacc[i][e] += (num[e] + w * qc[e]) * dd;
        }
    }
    const float* ng = A.in(I_MLNG) + l * 256 + h * 64 + ec * 4;
#pragma unroll
    for (int i = 0; i < 4; ++i) {
        const int j = jr + 32 * i, m = seqbase + tc * 128 + j;
        float s = (hacc[i][0] + hacc[i][1]) + (hacc[i][2] + hacc[i][3]);
        s += __shfl_xor(s, 1); s += __shfl_xor(s, 2); s += __shfl_xor(s, 4); s += __shfl_xor(s, 8);
        const float mean = s * (1.f / 64.f);
        float q = 0.f;
#pragma unroll
        for (int e = 0; e < 4; ++e) { const float dl = hacc[i][e] - mean; q += dl * dl; }
        q += __shfl_xor(q, 1); q += __shfl_xor(q, 2); q += __shfl_xor(q, 4); q += __shfl_xor(q, 8);
        const float rstd = 1.0f / sqrtf(q * (1.f / 64.f) + 1e-6f);
        const u32x2 ow = *(const u32x2*)(P + (size_t)m * PINP + C_ML + 768 + h * 64 + ec * 4);
        const float og[4] = {lo16(ow.x), hi16(ow.x), lo16(ow.y), hi16(ow.y)};
        float r[4];
#pragma unroll
        for (int e = 0; e < 4; ++e) r[e] = (hacc[i][e] - mean) * rstd * ng[e] * sigmoidf_(og[e]);
        u32x2 w; w.x = pk2(r[0], r[1]); w.y = pk2(r[2], r[3]);
        *(u32x2*)((bf16*)(A.ws + WS_YC) + (size_t)m * 1024 + 256 + h * 64 + ec * 4) = w;
    }
    __syncthreads();
}

__device__ __forceinline__ float rdl(float v, int l) { return __uint_as_float((unsigned)__builtin_amdgcn_readlane((int)__float_as_uint(v), l)); }
__device__ __forceinline__ float rw_shift(const bf16* P, const float* mu, int seqbase, int L, int tk, int col) {
    const bf16* p = P + (size_t)(seqbase + tk) * PINP + C_RW + col;
    const float c = bf2f(p[0]);
    const float pv = tk > 0 ? bf2f(p[-PINP]) : 0.f, nx = tk < L - 1 ? bf2f(p[PINP]) : 0.f;
    return c + mu[col] * (0.5f * (pv + nx) - c);
}

__device__ __forceinline__ void rw_local_wave(const KA& A, int l, int it, float* wl  , int lane) {
    const ChunkItem x = decode_item(it);
    const bf16* P = (const bf16*)(A.ws + WS_P);
    const float* mu = A.in(I_RWMU) + l * 1024;
    const int hc = x.h * 64 + lane;
    const float* w2 = A.in(I_RWW2) + ((size_t)(l * 2 + x.dir) * 64) * 256 + hc;
    const float* a2 = A.in(I_RWA2) + ((size_t)(l * 2 + x.dir) * 64) * 256 + hc;
    const float w0 = A.in(I_RWW0)[(l * 2 + x.dir) * 256 + hc], a0 = A.in(I_RWA0)[(l * 2 + x.dir) * 256 + hc];
    const float kkw = A.in(I_RWKK)[l * 256 + hc], kaw = A.in(I_RWKA)[l * 256 + hc];
    float S[64], Pm[64];
#pragma unroll
    for (int k = 0; k < 64; ++k) { S[k] = 0.f; Pm[k] = (k == lane) ? 1.f : 0.f; }
    bf16* yo = (bf16*)(A.ws + WS_RWY) + ((size_t)x.dir * NTOK * 4) * 128;
#pragma unroll 1
    for (int j0 = 0; j0 < 128; j0 += 8) {
#pragma unroll 1
        for (int u = 0; u < 8; ++u) { const int jl = x.c * 128 + j0 + u, tk = x.dir ? x.L - 1 - jl : jl; float* o = wl + u * 384;
            o[lane] = rw_shift(P, mu, x.seqbase, x.L, tk, hc); o[128 + lane] = rw_shift(P, mu, x.seqbase, x.L, tk, 256 + hc); o[320 + lane] = rw_shift(P, mu, x.seqbase, x.L, tk, 512 + hc);
            o[64 + lane] = tanhf(rw_shift(P, mu, x.seqbase, x.L, tk, 768 + lane)); o[256 + lane] = rw_shift(P, mu, x.seqbase, x.L, tk, 832 + lane); }
        LDS_WAIT();
        float wacc[8], aacc[8];
#pragma unroll
        for (int u = 0; u < 8; ++u) { wacc[u] = w0; aacc[u] = a0; }
#pragma unroll 1
        for (int jr = 0; jr < 64; jr += 4) {
            const float w20 = w2[(size_t)jr * 256], w21 = w2[(size_t)(jr + 1) * 256], w22 = w2[(size_t)(jr + 2) * 256], w23 = w2[(size_t)(jr + 3) * 256];
            const float a20 = a2[(size_t)jr * 256], a21 = a2[(size_t)(jr + 1) * 256], a22 = a2[(size_t)(jr + 2) * 256], a23 = a2[(size_t)(jr + 3) * 256];
#pragma unroll
            for (int u = 0; u < 8; ++u) { const f32x4 t4 = *(const f32x4*)(wl + u * 384 + 64 + jr), l4 = *(const f32x4*)(wl + u * 384 + 256 + jr);
                wacc[u] += t4[0] * w20 + t4[1] * w21 + t4[2] * w22 + t4[3] * w23; aacc[u] += l4[0] * a20 + l4[1] * a21 + l4[2] * a22 + l4[3] * a23; } }
        LDS_WAIT();
#pragma unroll
        for (int u = 0; u < 8; ++u) {
            float* o = wl + u * 384;
            const float w = __expf(-0.606531f * sigmoidf_(wacc[u])), a = sigmoidf_(aacc[u]);
            const float kr = o[128 + lane];
            float kn = kr * kkw; const float nr = sqrtf(wave_sum(kn * kn)); kn = kn / fmaxf(nr, 1e-12f);
            o[64 + lane] = w; o[128 + lane] = kr * (1.0f + (a - 1.0f) * kaw); o[192 + lane] = -kn; o[256 + lane] = kn * a;
        }
        LDS_WAIT();
#pragma unroll 1
        for (int u = 0; u < 8; ++u) {
            const float* o = wl + u * 384;
            float sa = 0.f, sp = 0.f;
#pragma unroll
            for (int k = 0; k < 64; k += 4) { const f32x4 av = *(const f32x4*)(o + 192 + k);
                sa += S[k] * av[0] + S[k + 1] * av[1] + S[k + 2] * av[2] + S[k + 3] * av[3];
                sp += Pm[k] * av[0] + Pm[k + 1] * av[1] + Pm[k + 2] * av[2] + Pm[k + 3] * av[3];
                if ((k & 12) == 12) asm volatile("" ::: "memory"); }
            const float vcur = o[320 + lane];
            float y = 0.f, uu = 0.f;
#pragma unroll
            for (int k = 0; k < 64; k += 4) { const f32x4 wv = *(const f32x4*)(o + 64 + k), bv = *(const f32x4*)(o + 256 + k), kv = *(const f32x4*)(o + 128 + k), rv = *(const f32x4*)(o + k);
#pragma unroll
                for (int e = 0; e < 4; ++e) { S[k + e] = S[k + e] * wv[e] + sa * bv[e] + vcur * kv[e]; Pm[k + e] = Pm[k + e] * wv[e] + sp * bv[e]; y += S[k + e] * rv[e]; uu += Pm[k + e] * rv[e]; }
                if (k & 4) asm volatile("" ::: "memory"); }
            const int jl = x.c * 128 + j0 + u, tk = x.dir ? x.L - 1 - jl : jl;
            bf16* yr = yo + ((size_t)(x.seqbase + tk) * 4 + x.h) * 128;
            yr[lane] = (bf16)f2bf(y); yr[64 + lane] = (bf16)f2bf(uu);
        }
        LDS_WAIT();
    }
    float* pb = (float*)(A.ws + WS_RWB) + (size_t)it * 4096 + lane * 64;
    float* pp = (float*)(A.ws + WS_RWP) + (size_t)it * 4096 + lane * 64;
#pragma unroll
    for (int k = 0; k < 64; k += 4) { *(f32x4*)(pb + k) = (f32x4){S[k], S[k + 1], S[k + 2], S[k + 3]}; *(f32x4*)(pp + k) = (f32x4){Pm[k], Pm[k + 1], Pm[k + 2], Pm[k + 3]}; }
}

__device__ __forceinline__ void rw_scan_chain(const KA& A, int l, int ch, unsigned char* lds, int tid) {
    const int g = ch >= 256, cl = g ? ch - 256 : ch, b = cl >> 3, h = (cl >> 1) & 3, dir = cl & 1, nc = g ? 32 : 2;
    const size_t sidx = (((size_t)(b * 4 + l) * 2 + dir) * 4 + h);
    float* Sl = (float*)lds;
    float* Pl = Sl + 2 * 64 * 68;
    const int v = tid >> 3, kq = tid & 7;
    float sown[8];
    { const float* s0 = A.in(I_RWS) + sidx * 4096 + v * 64 + kq * 8;
#pragma unroll
      for (int e = 0; e < 8; ++e) sown[e] = g ? s0[e] : 0.f; }
    __syncthreads();
#pragma unroll
    for (int e = 0; e < 8; ++e) Sl[v * 68 + kq * 8 + e] = sown[e];
    float pc[8], bc[8];
    { const int it = item_of(g, b, h, dir, 0); const float* pp = (const float*)(A.ws + WS_RWP) + (size_t)it * 4096 + tid * 8; const float* pb = (const float*)(A.ws + WS_RWB) + (size_t)it * 4096 + tid * 8;
#pragma unroll
      for (int e = 0; e < 8; ++e) { pc[e] = pp[e]; bc[e] = pb[e]; } }
    for (int c = 0; c < nc; ++c) {
        const int it = item_of(g, b, h, dir, c);
        const float* Sc = Sl + (c & 1) * 64 * 68; float* Sn = Sl + ((c + 1) & 1) * 64 * 68;
#pragma unroll
        for (int e = 0; e < 8; ++e) Pl[tid * 8 + e] = pc[e];
        float snew[8];
#pragma unroll
        for (int e = 0; e < 8; ++e) snew[e] = bc[e];
        { float* sb = (float*)(A.ws + WS_RWB) + (size_t)it * 4096 + tid * 8;
#pragma unroll
          for (int e = 0; e < 8; ++e) sb[e] = sown[e]; }
        if (c + 1 < nc) { const int i2 = item_of(g, b, h, dir, c + 1); const float* pp = (const float*)(A.ws + WS_RWP) + (size_t)i2 * 4096 + tid * 8; const float* pb = (const float*)(A.ws + WS_RWB) + (size_t)i2 * 4096 + tid * 8;
#pragma unroll
            for (int e = 0; e < 8; ++e) { pc[e] = pp[e]; bc[e] = pb[e]; } }
        __syncthreads();
        for (int k4 = 0; k4 < 64; k4 += 4) { const f32x4 sv = *(const f32x4*)(Sc + v * 68 + k4);
#pragma unroll
            for (int u = 0; u < 4; ++u) { const f32x4 p0 = *(const f32x4*)(Pl + (k4 + u) * 64 + kq * 8), p1 = *(const f32x4*)(Pl + (k4 + u) * 64 + kq * 8 + 4); const float s = sv[u];
                snew[0] += s * p0[0]; snew[1] += s * p0[1]; snew[2] += s * p0[2]; snew[3] += s * p0[3]; snew[4] += s * p1[0]; snew[5] += s * p1[1]; snew[6] += s * p1[2]; snew[7] += s * p1[3]; } }
#pragma unroll
        for (int e = 0; e < 8; ++e) { sown[e] = snew[e]; Sn[v * 68 + kq * 8 + e] = snew[e]; }
        __syncthreads();
    }
    if (!g) { float* o = A.out + O_RS + sidx * 4096 + v * 64 + kq * 8;
#pragma unroll
        for (int e = 0; e < 8; ++e) o[e] = sown[e]; }
}

__device__ __forceinline__ void rw_out_item(const KA& A, int l, int item, int lane, int wave) {
    int g, b, h, tc, L, nc, seqbase;
    if (item < 256) { g = 0; tc = item & 1; const int bh = item >> 1; b = bh >> 2; h = bh & 3; L = 256; nc = 2; seqbase = b * 256; }
    else { const int i2 = item - 256; g = 1; tc = i2 & 31; const int bh = i2 >> 5; b = bh >> 2; h = bh & 3; L = 4096; nc = 32; seqbase = NCTX + b * 4096; }
    const bf16* P = (const bf16*)(A.ws + WS_P);
    const float* mu = A.in(I_RWMU) + l * 1024;
    const int hc = h * 64 + lane;
    const float kaw = A.in(I_RWKA)[l * 256 + hc], rkw = A.in(I_RWRK)[l * 256 + hc], lng = A.in(I_RWLNG)[l * 256 + hc], lnb = A.in(I_RWLNB)[l * 256 + hc];
    const float* g2 = A.in(I_RWG2) + (size_t)l * 128 * 256 + hc;
    for (int rnd = 0; rnd < 2; ++rnd) {
        const int tk0 = tc * 128 + wave * 16 + rnd * 8;
        float rr[8], kk[8], vv[8], la[8], sg0[8], sg1[8], ysum[8], bon[8], gg[8];
#pragma unroll
        for (int u = 0; u < 8; ++u) { const int tk = tk0 + u;
            rr[u] = rw_shift(P, mu, seqbase, L, tk, hc); kk[u] = rw_shift(P, mu, seqbase, L, tk, 256 + hc); vv[u] = rw_shift(P, mu, seqbase, L, tk, 512 + hc);
            la[u] = rw_shift(P, mu, seqbase, L, tk, 832 + lane);
            sg0[u] = sigmoidf_(rw_shift(P, mu, seqbase, L, tk, 896 + lane)); sg1[u] = sigmoidf_(rw_shift(P, mu, seqbase, L, tk, 960 + lane));
            ysum[u] = 0.f; bon[u] = 0.f; gg[u] = 0.f; }
        for (int j = 0; j < 64; ++j) { const float g0v = g2[(size_t)j * 256], g1v = g2[(size_t)(64 + j) * 256];
#pragma unroll
            for (int u = 0; u < 8; ++u) gg[u] += rdl(sg0[u], j) * g0v + rdl(sg1[u], j) * g1v; }
        for (int dir = 0; dir < 2; ++dir) {
            const float* a2 = A.in(I_RWA2) + ((size_t)(l * 2 + dir) * 64) * 256 + hc; const float a0 = A.in(I_RWA0)[(l * 2 + dir) * 256 + hc];
            float aacc[8];
#pragma unroll
            for (int u = 0; u < 8; ++u) aacc[u] = a0;
            for (int j = 0; j < 64; ++j) { const float a2v = a2[(size_t)j * 256];
#pragma unroll
                for (int u = 0; u < 8; ++u) aacc[u] += rdl(la[u], j) * a2v; }
            const int c = dir ? nc - 1 - tc : tc;
            const float* s0 = (const float*)(A.ws + WS_RWB) + (size_t)item_of(g, b, h, dir, c) * 4096 + lane * 64;
            float S0[64];
#pragma unroll
            for (int k = 0; k < 64; k += 4) { const f32x4 t = *(const f32x4*)(s0 + k); S0[k] = t[0]; S0[k + 1] = t[1]; S0[k + 2] = t[2]; S0[k + 3] = t[3]; }
            const bf16* yo = (const bf16*)(A.ws + WS_RWY) + ((size_t)dir * NTOK * 4) * 128;
#pragma unroll
            for (int u = 0; u < 8; ++u) {
                const bf16* yr = yo + ((size_t)(seqbase + tk0 + u) * 4 + h) * 128;
                float y = bf2f(yr[lane]); const float uv = bf2f(yr[64 + lane]);
#pragma unroll
                for (int k = 0; k < 64; ++k) y += S0[k] * rdl(uv, k);
                ysum[u] += y;
                const float a = sigmoidf_(aacc[u]), kt = kk[u] * (1.0f + (a - 1.0f) * kaw);
                bon[u] += wave_sum(rr[u] * kt * rkw) * vv[u];
            }
        }
#pragma unroll
        for (int u = 0; u < 8; ++u) {
            const float mean = wave_sum(ysum[u]) * (1.f / 64.f), dl = ysum[u] - mean, var = wave_sum(dl * dl) * (1.f / 64.f);
            const float yn = dl * (1.0f / sqrtf(var + 64e-5f)) * lng + lnb;
            ((bf16*)(A.ws + WS_YC))[(size_t)(seqbase + tk0 + u) * 1024 + 512 + hc] = (bf16)f2bf((yn + bon[u]) * gg[u]);
        }
    }
}

__device__ __forceinline__ void hy_out_item(const KA& A, int item, unsigned char* lds, int tid) {
    const int tile = item >> 2, cb = item & 3, m0 = tile * 64;
    bf16* T = (bf16*)lds;
    const bf16* yT = (const bf16*)(A.ws + WS_XT);
    { const int ch = tid >> 3, tg = tid & 7; const u32x4 w = *(const u32x4*)(yT + (size_t)(cb * 64 + ch) * NTOK + m0 + tg * 8);
      const unsigned ww[4] = {w.x, w.y, w.z, w.w};
#pragma unroll
      for (int e = 0; e < 4; ++e) { T[(tg * 8 + 2 * e) * 72 + ch] = (bf16)(ww[e] & 0xffffu); T[(tg * 8 + 2 * e + 1) * 72 + ch] = (bf16)(ww[e] >> 16); } }
    __syncthreads();
    { const int tok = tid >> 3, cg = tid & 7; const u32x4 w = *(const u32x4*)(T + tok * 72 + cg * 8);
      *(u32x4*)((bf16*)(A.ws + WS_YC) + (size_t)(m0 + tok) * 1024 + cb * 64 + cg * 8) = w; }
    __syncthreads();
}

#ifndef EN_HY
#define EN_HY 1
#endif
#ifndef EN_RWL
#define EN_RWL 1
#endif
#ifndef EN_AT
#define EN_AT 1
#endif
#ifndef EN_MLL
#define EN_MLL 1
#endif
#ifndef EN_RWO
#define EN_RWO 1
#endif
#ifndef EN_MLO
#define EN_MLO 1
#endif
#ifndef EN_P2
#define EN_P2 1
#endif
#ifndef EN_P4
#define EN_P4 1
#endif
#ifndef EN_GEMM
#define EN_GEMM 7
#endif

__device__ __forceinline__ int q_next(unsigned* head, unsigned char* lds, int tid) {
    __syncthreads();
    if (tid == 0) *(volatile int*)(lds + LDS_SLOT) = (int)atomicAdd(head, 1u);
    __syncthreads();
    return *(volatile int*)(lds + LDS_SLOT);
}

__device__ __forceinline__ void phase3(const KA& A, int l, unsigned char* lds, int tid0, int wave) {
    unsigned* head = (unsigned*)(A.ws + WS_CTL) + CW_Q + 64 * l;
    constexpr int N_HYL = 256, N_RW = 128, N_ATL = 128, N_HYC = 256, N_ATC = 128, N_ML = 1024;
    const int n_wc = (l < 3) ? 100 : 72;
    const int total = N_HYL + N_RW + N_ATL + N_HYC + N_ATC + N_ML + n_wc;
    for (;;) {
        int tid = tid0; asm volatile("" : "+v"(tid)); const int lane = tid & 63;
        int it = q_next(head, lds, tid);
        if (it >= total) break;
        if (it < N_HYL) { if (EN_HY) hy_unit(A, l, 1, it, lds, tid, lane, wave); continue; } it -= N_HYL;
        if (it < N_RW) { if (EN_RWL) rw_local_wave(A, l, it * 8 + wave, (float*)lds + wave * 3072, lane); continue; } it -= N_RW;
        if (it < N_ATL) { if (EN_AT) attn_unit(A, 1, it >> 6, (it >> 5) & 1, it & 31, lds, tid, lane, wave); continue; } it -= N_ATL;
        if (it < N_HYC) { if (EN_HY) hy_unit(A, l, 0, it, lds, tid, lane, wave); continue; } it -= N_HYC;
        if (it < N_ATC) { if (EN_AT) attn_unit(A, 0, it >> 2, (it >> 1) & 1, it & 1, lds, tid, lane, wave); continue; } it -= N_ATC;
        if (it < N_ML) { if (EN_MLL) ml_local_item(A, l, it, lds, tid, lane, wave); continue; } it -= N_ML;
        if (it < 8) { wconv_block(A.in(I_WOUT) + (size_t)l * 1024 * 1024, 1024, 1024, 1024, (bf16*)(A.ws + WS_WOUT), it * 64, 64, lds, wave, lane); continue; } it -= 8;
        if (it < 32) { wconv_block(A.in(I_W1) + (size_t)l * 1024 * 4096, 1024, 4096, 4096, (bf16*)(A.ws + WS_W1), it * 64, 64, lds, wave, lane); continue; } it -= 32;
        if (it < 32) { wconv_block(A.in(I_W2) + (size_t)l * 4096 * 1024, 4096, 1024, 1024, (bf16*)(A.ws + WS_W2), it * 64, 64, lds, wave, lane); continue; } it -= 32;
        wconv_block(A.in(I_WIN) + (size_t)(l + 1) * 1024 * PIN, 1024, PIN, PINP, (bf16*)(A.ws + WS_WIN), it * 64, 64, lds, wave, lane);
    }
}
__device__ __forceinline__ void phase4(const KA& A, int l, unsigned char* lds, int tid0, int bid, int G) {
    for (int it = bid; it < 544; it += G) {
        int tid = tid0; asm volatile("" : "+v"(tid));
        if (it < 16) rw_scan_chain(A, l, 256 + it, lds, tid);
        else if (it < 32) ml_scan_chain(A, l, 256 + it - 16, tid);
        else if (it < 288) rw_scan_chain(A, l, it - 32, lds, tid);
        else ml_scan_chain(A, l, it - 288, tid);
        __syncthreads();
    }
}
__device__ __forceinline__ void phase5(const KA& A, int l, unsigned char* lds, int tid0, int wave, int bid, int G) {
    for (int it = bid; it < 2048; it += G) {
        int tid = tid0; asm volatile("" : "+v"(tid)); const int lane = tid & 63;
        if (it < 512) { if (EN_RWO) rw_out_item(A, l, it, lane, wave); }
        else if (it < 1024) { if (EN_MLO) ml_out_item(A, l, it - 512, lds, tid, lane, wave); }
        else hy_out_item(A, it - 1024, lds, tid);
    }
}

__global__ void __launch_bounds__(NTHR, 2) mega_fwd(Args KARG) {
    extern __shared__ __attribute__((aligned(16))) unsigned char lds[];
    cg::grid_group grid = cg::this_grid();
    const int tid0 = threadIdx.x, bid0 = blockIdx.x, G0 = gridDim.x;
    { const int tid = tid0; unsigned long long pv = 0ull;
#pragma unroll
      for (int i = 0; i < 43; ++i) pv = (tid == i) ? (unsigned long long)KARG.in[i] : pv;
      if (tid < 43) *(unsigned long long*)(lds + LDS_TAB + tid * 8) = pv; }
    __syncthreads();
    KA A; A.out = KARG.out; A.ws = KARG.ws; A.lds = lds;
    const int ph_lo = KARG.ph_lo, ph_hi = KARG.ph_hi;
    for (int ph = ph_lo; ph < ph_hi; ++ph) {
        int tid = tid0, bid = bid0, G = G0;
        asm volatile("" : "+v"(tid)); asm volatile("" : "+s"(bid), "+s"(G));
        { unsigned long long w_ = (unsigned long long)KARG.ws, o_ = (unsigned long long)KARG.out; asm volatile("" : "+s"(w_), "+s"(o_)); A.ws = (unsigned char*)w_; A.out = (float*)o_; }
        unsigned char* ws = A.ws; const float* mod = (const float*)(ws + WS_MOD);
        const int lane = tid & 63, wave = __builtin_amdgcn_readfirstlane(tid >> 6);
        if (ph == 0) phase0(A, lds, tid, wave, lane, bid, G);
        else if (ph == 1) phase_mod0(A, wave, lane, bid, G);
        else {
            const int l = (ph - 2) / 10, s = (ph - 2) % 10;
            const float* modl = mod + (size_t)l * 3 * 6144;
            if (s == 0) { if (EN_GEMM & 1) {
                pg8::Gemm g{(const bf16*)(ws + WS_H), (const bf16*)(ws + WS_WIN), NTOK, PINP, 1024}; pg8::StaticOrder S; S.init(NTOK, PINP, G, bid);
                pg8::EpiBf16<0> E{(bf16*)(ws + WS_P), PINP};
                pg8::gemm_phase<pg8::EpiBf16<0>, pg8::StaticOrder, true, true>((PG8_LAS unsigned char*)lds, g, S, E); }
            } else if (s == 1) { if (EN_P2) phase2(A, l, lds, tid, bid, G); }
            else if (s == 2) phase3(A, l, lds, tid, wave);
            else if (s == 3) { if (EN_P4) phase4(A, l, lds, tid, bid, G); }
            else if (s == 4) phase5(A, l, lds, tid, wave, bid, G);
            else if (s == 5 || s == 8) { if (EN_GEMM & 2) {
                const bool first = (s == 5);
                pg8::Gemm g{first ? (const bf16*)(ws + WS_YC) : (const bf16*)(ws + WS_P), first ? (const bf16*)(ws + WS_WOUT) : (const bf16*)(ws + WS_W2), NTOK, 1024, first ? 1024 : 4096};
                pg8::StaticOrder S; S.init(NTOK, 1024, G, bid);
                const float* b0 = (first && l == 0) ? A.in(I_XP) : A.out; const float* b1 = (first && l == 0) ? A.in(I_XS) : A.out + (size_t)NCTX * 1024;
                pg8::EpiRes E{b0, b1, A.out, modl + (first ? 2 : 5) * 1024, ALPHA};
                pg8::gemm_phase<pg8::EpiRes, pg8::StaticOrder, true, true>((PG8_LAS unsigned char*)lds, g, S, E); }
            } else if (s == 6) phase_ln(A, A.in(I_LN1G) + l * 1024, A.in(I_LN1B) + l * 1024, modl, 3 * 1024, wave, lane, bid, G);
            else if (s == 7) { if (EN_GEMM & 4) {
                pg8::Gemm g{(const bf16*)(ws + WS_H), (const bf16*)(ws + WS_W1), NTOK, DFF, 1024}; pg8::StaticOrder S; S.init(NTOK, DFF, G, bid);
                pg8::EpiBf16<2> E{(bf16*)(ws + WS_P), DFF};
                pg8::gemm_phase<pg8::EpiBf16<2>, pg8::StaticOrder, true, true>((PG8_LAS unsigned char*)lds, g, S, E); }
            } else phase_ln(A, A.in(I_LN2G) + l * 1024, A.in(I_LN2B) + l * 1024, l < 3 ? modl + 3 * 6144 : nullptr, 0, wave, lane, bid, G);
        }
        if (ph + 1 < ph_hi) grid.sync();
    }
}

constexpr int N_PHASES = 42;
extern "C" void kernel_launch(void* const* d_in, const int* in_sizes, int n_in, void* d_out, int out_size, void* d_ws, size_t ws_size, hipStream_t stream) {
    static int grid = 0;
    if (grid == 0) {
        if (n_in != 43 || ws_size < WS_END) { fprintf(stderr, "kernel_launch: unexpected inputs (n_in %d, ws %zu)\n", n_in, ws_size); grid = -1; return; }
        int dev = 0, cus = 0, per_cu = 0;
        hipGetDevice(&dev);
        hipDeviceGetAttribute(&cus, hipDeviceAttributeMultiprocessorCount, dev);
        if (hipFuncSetAttribute((const void*)mega_fwd, hipFuncAttributeMaxDynamicSharedMemorySize, LDS_BYTES) != hipSuccess) { fprintf(stderr, "kernel_launch: hipFuncSetAttribute failed\n"); grid = -1; return; }
        hipOccupancyMaxActiveBlocksPerMultiprocessor(&per_cu, (const void*)mega_fwd, NTHR, LDS_BYTES);
        (void)hipGetLastError();
        if (per_cu < 1) { fprintf(stderr, "kernel_launch: occupancy query says %d blocks per CU\n", per_cu); per_cu = 1; }
        grid = cus;
    }
    if (grid < 0) return;
    hipMemsetAsync((char*)d_ws + WS_CTL, 0, 65536, stream);
    Args a{};
    for (int i = 0; i < 43; ++i) a.in[i] = (const float*)d_in[i];
    a.out = (float*)d_out; a.ws = (unsigned char*)d_ws;
#ifndef MK_SPLIT
    a.ph_lo = 0; a.ph_hi = N_PHASES;
    void* args[] = {&a};
    hipError_t e = hipLaunchCooperativeKernel((const void*)mega_fwd, dim3(grid), dim3(NTHR), args, LDS_BYTES, stream);
    if (e != hipSuccess) fprintf(stderr, "cooperative launch failed: %s (grid %d)\n", hipGetErrorString(e), grid);
#else
    for (int ph = 0; ph < N_PHASES; ++ph) { a.ph_lo = ph; a.ph_hi = ph + 1; hipLaunchKernelGGL(mega_fwd, dim3(grid), dim3(NTHR), LDS_BYTES, stream, a); }
#endif
}
```

```cpp
#include <hip/hip_runtime.h>
#include <hip/hip_cooperative_groups.h>
#include <cstdio>
#include <cstdint>
#include <cmath>
namespace cg = cooperative_groups;

constexpr int DM = 1024, NTOK = 16384, NCTX = 8192, PIN = 3344, PINP = 3584, DFF = 4096, DEPTH = 4;
constexpr int C_HY = 0, C_ML = 768, C_RW = 1808, C_AT = 2832;
constexpr int C_MLG = C_ML + 1024;
constexpr float ALPHA = 1.6817928305074290f;
constexpr float QSCALE = 0.125f * 1.4426950408889634f;
constexpr int NTHR = 512, NWAVE = 8;

constexpr size_t MiB = 1u << 20;
constexpr size_t WS_CTL = 0;
constexpr size_t WS_MOD = 1 * MiB;
constexpr size_t WS_ROPE = WS_MOD + 512 * 1024;
constexpr size_t WS_WIN = 2 * MiB;
constexpr size_t WS_WOUT = WS_WIN + 7 * MiB;
constexpr size_t WS_W1 = WS_WOUT + 2 * MiB;
constexpr size_t WS_W2 = WS_W1 + 8 * MiB;
constexpr size_t WS_P = WS_W2 + 8 * MiB;
constexpr size_t WS_H = WS_P + 128 * MiB;
constexpr size_t WS_YC = WS_H + 32 * MiB;
constexpr size_t WS_FILT = WS_YC + 32 * MiB;
constexpr size_t FILT_LAT_OFF = 2 * 256 * 512 * 2;
constexpr size_t WS_PART = WS_FILT + 9 * MiB;
constexpr size_t WS_XT = WS_PART + 1 * MiB;
constexpr size_t WS_QB = WS_XT + 24 * MiB;
constexpr size_t WS_KBC = WS_QB + 8 * MiB;
constexpr size_t WS_VTC = WS_KBC + 2 * MiB;
constexpr size_t WS_KBL = WS_VTC + 2 * MiB;
constexpr size_t WS_VTL = WS_KBL + 3 * MiB;
constexpr size_t WS_MLS = WS_VTL + 3 * MiB;
constexpr int MLS_STRIDE = 4224;
constexpr size_t WS_RWP = WS_MLS + 17 * MiB;
constexpr size_t WS_RWB = WS_RWP + 16 * MiB;
constexpr size_t WS_RWY = WS_RWB + 16 * MiB;
constexpr size_t WS_YT = WS_RWY + 32 * MiB;
constexpr size_t WS_END = WS_YT + 8 * MiB;
static_assert(WS_END <= 384 * MiB, "workspace map");

constexpr int CW_Q = 64;

typedef unsigned short bf16;
typedef unsigned u32x4 __attribute__((ext_vector_type(4)));
typedef unsigned u32x2 __attribute__((ext_vector_type(2)));
typedef float f32x4 __attribute__((ext_vector_type(4)));
typedef float f32x16 __attribute__((ext_vector_type(16)));
typedef short bf16x8 __attribute__((ext_vector_type(8)));

__device__ __forceinline__ float bf2f(unsigned u) { return __uint_as_float(u << 16); }
__device__ __forceinline__ unsigned f2bf(float f) { unsigned u = __float_as_uint(f); return (u + 0x7fffu + ((u >> 16) & 1u)) >> 16; }
__device__ __forceinline__ unsigned pk2(float lo, float hi) { return f2bf(lo) | (f2bf(hi) << 16); }
__device__ __forceinline__ float lo16(unsigned w) { return __uint_as_float(w << 16); }
__device__ __forceinline__ float hi16(unsigned w) { return __uint_as_float(w & 0xffff0000u); }
__device__ __forceinline__ float wave_sum(float v) {
#pragma unroll
    for (int o = 1; o < 64; o <<= 1) v += __shfl_xor(v, o);
    return v;
}
__device__ __forceinline__ float wave_max(float v) {
#pragma unroll
    for (int o = 1; o < 64; o <<= 1) v = fmaxf(v, __shfl_xor(v, o));
    return v;
}
__device__ __forceinline__ float sigmoidf_(float x) { return 1.0f / (1.0f + __expf(-x)); }
__device__ __forceinline__ float logsigmoidf_(float x) { return fminf(x, 0.f) - log1pf(__expf(-fabsf(x))); }
__device__ __forceinline__ void unpack8(const u32x4 w, float* f) {
    f[0] = lo16(w.x); f[1] = hi16(w.x); f[2] = lo16(w.y); f[3] = hi16(w.y); f[4] = lo16(w.z); f[5] = hi16(w.z); f[6] = lo16(w.w); f[7] = hi16(w.w);
}

struct Args {
    const float* in[43];
    float* out;
    unsigned char* ws;
    int ph_lo, ph_hi;
};
constexpr int LDS_BYTES = 147456;
constexpr int LDS_SLOT = LDS_BYTES - 16;
constexpr int LDS_TAB = LDS_BYTES - 512;
struct KA {
    float* out; unsigned char* ws; const unsigned char* lds;
    __device__ __forceinline__ const float* in(int i) const {
        const u32x2 v = *(const u32x2*)(lds + LDS_TAB + i * 8);
        const unsigned lo = __builtin_amdgcn_readfirstlane(v.x), hi = __builtin_amdgcn_readfirstlane(v.y);
        return (const float*)(((unsigned long long)hi << 32) | lo);
    }
};
namespace pg8 {
#define PG8_LAS __attribute__((address_space(3)))
typedef unsigned short bf16_t;
typedef short bf16x8 __attribute__((ext_vector_type(8)));
typedef float f32x4 __attribute__((ext_vector_type(4)));
typedef unsigned u32x4 __attribute__((ext_vector_type(4)));
constexpr int BM = 256, BK = 64, HALF = 128, HTB = HALF * BK * 2  , STAGE_BYTES = 8 * HTB, NXCD = 8, WGM = 8;

__host__ __device__ __forceinline__ int lds_byte(int r, int c) { const int st = (r >> 4) * 2 + (c >> 5), rr = r & 15, cc = c & 31, ob = rr * 64 + cc * 2; return st * 1024 + (ob ^ (((ob >> 9) & 1) << 5)); }
__host__ __device__ __forceinline__ void stage_rc(int b, int& R, int& C) { const int st = b / 1024, sb = b % 1024, swz = sb ^ (((sb >> 9) & 1) << 5); R = (st >> 1) * 16 + swz / 64; C = (st & 1) * 32 + (swz % 64) / 2; }
__host__ __device__ __forceinline__ int perm32(int rho) { const int n = rho >> 4, i = rho & 15; return 8 * (i >> 2) + 4 * n + (i & 3); }

struct Unit { int pm, pn; };
struct Gemm { const bf16_t* A; const bf16_t* Bt; int M, N, K; };

struct StaticOrder {
    int nM, nN, nwg, G, c;
    __host__ __device__ void init(int M, int N, int G_, int c_) { nM = M / BM; nN = N / BM; nwg = nM * nN; G = G_; c = c_; }
    __host__ __device__ bool next(int i, Unit& u) const {
        const long L = (long)i * G + c; if (L >= nwg) return false;
        int wgid = (int)L; { const int q = nwg / NXCD, r = nwg % NXCD, xcd = wgid % NXCD, off = wgid / NXCD; wgid = (xcd < r ? xcd * (q + 1) : r * (q + 1) + (xcd - r) * q) + off; }
        const int nig = WGM * nN, gid = wgid / nig, fm = gid * WGM, gsz = (nM - fm) < WGM ? (nM - fm) : WGM;
        u.pm = fm + ((wgid % nig) % gsz); u.pn = (wgid % nig) / gsz; return true;
    }
    __device__ __forceinline__ void a_ready(const Unit&) const {}
    __device__ __forceinline__ void done(const Unit&) const {}
};


__device__ __forceinline__ unsigned cvt_pk_bf16(float lo, float hi) { unsigned r; asm volatile("v_cvt_pk_bf16_f32 %0, %1, %2" : "=v"(r) : "v"(lo), "v"(hi)); return r; }

template <int ACT  > struct EpiBf16 {
    static constexpr bool PERM = true, AFTER_DRAIN = false;
    bf16_t* O; int ldc;
    __device__ __forceinline__ void operator()(const f32x4 (&acc)[2][2][4][2], const Unit& u, int wr, int wc, int fr, int fq) const {
        const int row0 = u.pm * BM + wr * 64 + fr; const int col0 = u.pn * BM + wc * 32 + 8 * fq;
#pragma unroll
        for (int ai = 0; ai < 2; ++ai)
#pragma unroll
            for (int m = 0; m < 4; ++m) { bf16_t* rowp = O + (size_t)(row0 + ai * HALF + m * 16) * ldc + col0;
#pragma unroll
                for (int bj = 0; bj < 2; ++bj) { f32x4 v0 = acc[ai][bj][m][0], v1 = acc[ai][bj][m][1];
                    if (ACT == 2) {
#pragma unroll
                        for (int e = 0; e < 4; ++e) { float a = fmaxf(v0[e], 0.f), b = fmaxf(v1[e], 0.f); v0[e] = a * a; v1[e] = b * b; } }
                    u32x4 w; w.x = cvt_pk_bf16(v0[0], v0[1]); w.y = cvt_pk_bf16(v0[2], v0[3]); w.z = cvt_pk_bf16(v1[0], v1[1]); w.w = cvt_pk_bf16(v1[2], v1[3]);
                    *(u32x4*)(rowp + bj * HALF) = w; } }
    }
};
struct EpiRes {
    static constexpr bool PERM = false, AFTER_DRAIN = false;
    const float* base0; const float* base1; float* out; const float* gate; float alpha;
    __device__ __forceinline__ void operator()(const f32x4 (&acc)[2][2][4][2], const Unit& u, int wr, int wc, int fr, int fq) const {
        const int cond = u.pm < 32 ? 0 : 1 + ((u.pm - 32) >> 4);
        const float* g = gate + cond * 6144;
        const float* bs = u.pm < 32 ? base0 : base1 - (size_t)8192 * 1024;
        const int col0 = u.pn * BM + wc * 32 + 4 * fq;
        f32x4 gv[2][2];
#pragma unroll
        for (int bj = 0; bj < 2; ++bj)
#pragma unroll
            for (int n = 0; n < 2; ++n) gv[bj][n] = *(const f32x4*)(g + col0 + bj * HALF + n * 16);
#pragma unroll
        for (int ai = 0; ai < 2; ++ai)
#pragma unroll
            for (int m = 0; m < 4; ++m) { const size_t off = (size_t)(u.pm * BM + ai * HALF + wr * 64 + m * 16 + fr) * 1024 + col0;
#pragma unroll
                for (int bj = 0; bj < 2; ++bj)
#pragma unroll
                    for (int n = 0; n < 2; ++n) { const f32x4 b = *(const f32x4*)(bs + off + bj * HALF + n * 16);
                        *(f32x4*)(out + off + bj * HALF + n * 16) = b * alpha + gv[bj][n] * acc[ai][bj][m][n]; } }
    }
};
template <class Epi, class Sched, bool ALIGN_EPI = false, bool SP2 = false>
__device__ __forceinline__ void gemm_phase(PG8_LAS unsigned char* lds, const Gemm g, const Sched& S, const Epi& E) {
    int tid_ = threadIdx.x; asm volatile("" : "+v"(tid_)); const int tid = tid_, wid = __builtin_amdgcn_readfirstlane(tid >> 6), lane = tid & 63, wr = wid >> 2, wc = wid & 3, fr = lane & 15, fq = lane >> 4;
    const int K = g.K, nt = K / BK;
    unsigned voffA[2], voffB[2];
#pragma unroll
    for (int i = 0; i < 2; ++i) { int R, C; stage_rc(tid * 16 + i * 8192, R, C); const int Rb = Epi::PERM ? ((R & ~31) + perm32(R & 31)) : R;
        voffA[i] = (unsigned)(R * K + C) * 2u; voffB[i] = (unsigned)(Rb * K + C) * 2u; }
    const size_t kstep = (size_t)(BK * 2);
    const size_t hstep = (size_t)HALF * K * 2;
    const size_t tstep = 2 * hstep;
    const unsigned ldsw = (unsigned)wid * 1024u;
    const int aoff = lds_byte(wr * 64 + fr, fq * 8), boff = lds_byte(wc * 32 + fr, fq * 8);
#define PG8_SA(b, h) (((b) * 2 + (h)) * HTB)
#define PG8_SB(b, h) ((4 + (b) * 2 + (h)) * HTB)
#define PG8_STAGE(bufoff, gbase, voff) do { _Pragma("unroll") for (int _i = 0; _i < 2; ++_i) \
        __builtin_amdgcn_global_load_lds((const unsigned*)((const char*)(gbase) + (voff)[_i]), (PG8_LAS unsigned*)(lds + (bufoff) + ldsw + _i * 8192), 16, 0, 0); } while (0)
#define PG8_LDA(dst, b, h) do { _Pragma("unroll") for (int m = 0; m < 4; ++m) _Pragma("unroll") for (int k = 0; k < 2; ++k) dst[m][k] = *(const PG8_LAS bf16x8*)(lds + PG8_SA(b, h) + aoff + m * 2048 + k * 1024); } while (0)
#define PG8_LDB(dst, b, h) do { _Pragma("unroll") for (int n = 0; n < 2; ++n) _Pragma("unroll") for (int k = 0; k < 2; ++k) dst[n][k] = *(const PG8_LAS bf16x8*)(lds + PG8_SB(b, h) + boff + n * 2048 + k * 1024); } while (0)
#define PG8_MMA(ai, bj, At, Bt) do { __builtin_amdgcn_s_setprio(1); _Pragma("unroll") for (int m = 0; m < 4; ++m) _Pragma("unroll") for (int n = 0; n < 2; ++n) _Pragma("unroll") for (int k = 0; k < 2; ++k) \
        acc[ai][bj][m][n] = __builtin_amdgcn_mfma_f32_16x16x32_bf16(Bt[n][k], At[m][k], acc[ai][bj][m][n], 0, 0, 0); __builtin_amdgcn_s_setprio(0); } while (0)
#define PG8_WAIT_V(n) asm volatile("s_waitcnt vmcnt(" #n ")" ::: "memory")
#define PG8_WAIT_L(n) asm volatile("s_waitcnt lgkmcnt(" #n ")" ::: "memory")
#define PG8_BAR __builtin_amdgcn_s_barrier()
#define PG8_SCHED __builtin_amdgcn_sched_barrier(0)
    Unit cur, nxt; int ui = 0;
    if (!S.next(0, cur)) return;
    f32x4 acc[2][2][4][2];
#pragma unroll
    for (int a = 0; a < 2; ++a)
#pragma unroll
        for (int b = 0; b < 2; ++b)
#pragma unroll
            for (int m = 0; m < 4; ++m)
#pragma unroll
                for (int n = 0; n < 2; ++n) acc[a][b][m][n] = (f32x4){0.f, 0.f, 0.f, 0.f};
    bf16x8 At[4][2], B0[2][2], B1[2][2];
    const char* cA = (const char*)g.A + (size_t)cur.pm * tstep; const char* cB = (const char*)g.Bt + (size_t)cur.pn * tstep;
    S.a_ready(cur);
    if constexpr (SP2) {
        PG8_STAGE(PG8_SB(0, 0), cB, voffB); PG8_STAGE(PG8_SB(0, 1), cB + hstep, voffB); PG8_STAGE(PG8_SA(0, 0), cA, voffA); PG8_STAGE(PG8_SA(0, 1), cA + hstep, voffA);
        if (wr == 1) PG8_BAR;
        PG8_WAIT_V(2); PG8_BAR;
        PG8_STAGE(PG8_SB(1, 0), cB + kstep, voffB); PG8_STAGE(PG8_SA(1, 0), cA + kstep, voffA); PG8_STAGE(PG8_SB(1, 1), cB + hstep + kstep, voffB);
        PG8_WAIT_V(6); PG8_BAR;
    } else {
        PG8_STAGE(PG8_SB(0, 0), cB, voffB); PG8_STAGE(PG8_SA(0, 0), cA, voffA); PG8_STAGE(PG8_SB(0, 1), cB + hstep, voffB); PG8_STAGE(PG8_SA(0, 1), cA + hstep, voffA);
        if (wr == 1) PG8_BAR;
        PG8_WAIT_V(4); PG8_BAR;
        PG8_STAGE(PG8_SB(1, 0), cB + kstep, voffB); PG8_STAGE(PG8_SA(1, 0), cA + kstep, voffA); PG8_STAGE(PG8_SB(1, 1), cB + hstep + kstep, voffB);
        PG8_WAIT_V(6); PG8_BAR;
    }
    for (;;) {
        const bool has_next = S.next(ui + 1, nxt);
        const char* nA = has_next ? (const char*)g.A + (size_t)nxt.pm * tstep : cA; const char* nB = has_next ? (const char*)g.Bt + (size_t)nxt.pn * tstep : cB;
        for (int t = 0; t < nt; t += 2) {
            const bool last = (t == nt - 2);
            const char* a1 = cA + (size_t)(t + 1) * kstep;
            const char* a2 = last ? nA : cA + (size_t)(t + 2) * kstep; const char* b2 = last ? nB : cB + (size_t)(t + 2) * kstep;
            const char* a3 = a2 + kstep; const char* b3 = b2 + kstep;
            if (last && has_next) S.a_ready(nxt);
            if constexpr (SP2) {
            PG8_LDB(B0, 0, 0); PG8_LDB(B1, 0, 1); PG8_SCHED; PG8_LDA(At, 0, 0); PG8_STAGE(PG8_SA(1, 1), a1 + hstep, voffA);
            PG8_WAIT_V(8); PG8_WAIT_L(0); PG8_BAR; PG8_MMA(0, 0, At, B0); PG8_MMA(0, 1, At, B1); PG8_BAR; PG8_SCHED;
            PG8_LDA(At, 0, 1); PG8_STAGE(PG8_SB(0, 0), b2, voffB); PG8_STAGE(PG8_SB(0, 1), b2 + hstep, voffB); PG8_STAGE(PG8_SA(0, 0), a2, voffA);
            PG8_WAIT_V(8); PG8_WAIT_L(0); PG8_BAR; PG8_MMA(1, 0, At, B0); PG8_MMA(1, 1, At, B1); PG8_BAR; PG8_SCHED;
            PG8_LDB(B0, 1, 0); PG8_LDB(B1, 1, 1); PG8_SCHED; PG8_LDA(At, 1, 0); PG8_STAGE(PG8_SA(0, 1), a2 + hstep, voffA);
            PG8_WAIT_V(8); PG8_WAIT_L(0); PG8_BAR; PG8_MMA(0, 0, At, B0); PG8_MMA(0, 1, At, B1); PG8_BAR; PG8_SCHED;
            PG8_LDA(At, 1, 1); PG8_STAGE(PG8_SB(1, 0), b3, voffB); PG8_STAGE(PG8_SB(1, 1), b3 + hstep, voffB); PG8_STAGE(PG8_SA(1, 0), a3, voffA);
            PG8_WAIT_V(8); PG8_WAIT_L(0); PG8_BAR; PG8_MMA(1, 0, At, B0); PG8_MMA(1, 1, At, B1); PG8_BAR; PG8_SCHED;
            } else {
            PG8_LDB(B0, 0, 0); PG8_SCHED; PG8_LDA(At, 0, 0); PG8_STAGE(PG8_SA(1, 1), a1 + hstep, voffA);
            PG8_WAIT_L(8); PG8_BAR; PG8_WAIT_L(0); PG8_MMA(0, 0, At, B0); PG8_BAR; PG8_SCHED;
            PG8_LDB(B1, 0, 1); PG8_STAGE(PG8_SB(0, 0), b2, voffB);
            PG8_BAR; PG8_WAIT_L(0); PG8_MMA(0, 1, At, B1); PG8_BAR;
            PG8_LDA(At, 0, 1); PG8_STAGE(PG8_SA(0, 0), a2, voffA);
            PG8_BAR; PG8_WAIT_L(0); PG8_MMA(1, 0, At, B0); PG8_BAR; PG8_SCHED;
            PG8_STAGE(PG8_SB(0, 1), b2 + hstep, voffB);
            PG8_WAIT_V(6); PG8_BAR; PG8_MMA(1, 1, At, B1); PG8_BAR;
            PG8_LDB(B0, 1, 0); PG8_SCHED; PG8_LDA(At, 1, 0); PG8_STAGE(PG8_SA(0, 1), a2 + hstep, voffA);
            PG8_WAIT_L(8); PG8_BAR; PG8_WAIT_L(0); PG8_MMA(0, 0, At, B0); PG8_BAR; PG8_SCHED;
            PG8_LDB(B1, 1, 1); PG8_STAGE(PG8_SB(1, 0), b3, voffB);
            PG8_BAR; PG8_WAIT_L(0); PG8_MMA(0, 1, At, B1); PG8_BAR;
            PG8_LDA(At, 1, 1); PG8_STAGE(PG8_SA(1, 0), a3, voffA);
            PG8_BAR; PG8_WAIT_L(0); PG8_MMA(1, 0, At, B0); PG8_BAR; PG8_SCHED;
            PG8_STAGE(PG8_SB(1, 1), b3 + hstep, voffB);
            PG8_WAIT_V(6); PG8_BAR; PG8_MMA(1, 1, At, B1); PG8_BAR;
            }
        }
        if constexpr (ALIGN_EPI) { if (wr == 0) PG8_BAR; }
        if constexpr (!Epi::AFTER_DRAIN) { E(acc, cur, wr, wc, fr, fq); S.done(cur); }
        if (!has_next) break;
#pragma unroll
        for (int a = 0; a < 2; ++a)
#pragma unroll
            for (int b = 0; b < 2; ++b)
#pragma unroll
                for (int m = 0; m < 4; ++m)
#pragma unroll
                    for (int n = 0; n < 2; ++n) acc[a][b][m][n] = (f32x4){0.f, 0.f, 0.f, 0.f};
        cur = nxt; cA = nA; cB = nB; ++ui;
        if constexpr (ALIGN_EPI) { if (wr == 1) PG8_BAR; }
    }
    PG8_WAIT_V(0);
    if constexpr (!ALIGN_EPI) { if (wr == 0) PG8_BAR; }
    PG8_BAR;
    if constexpr (Epi::AFTER_DRAIN) { E.fused(acc, cur, wr, wc, fr, fq, lds, wid, lane); S.done(cur); }
#undef PG8_SA
#undef PG8_SB
#undef PG8_STAGE
#undef PG8_LDA
#undef PG8_LDB
#undef PG8_MMA
#undef PG8_WAIT_V
#undef PG8_WAIT_L
#undef PG8_BAR
#undef PG8_SCHED
}
}

#define LDS_WAIT() asm volatile("s_waitcnt lgkmcnt(0)" ::: "memory")

enum { I_XP = 0, I_XS, I_CK, I_CV, I_MLC, I_MLN, I_MLM, I_RWS, I_C, I_CCTX, I_WMOD, I_BMOD, I_WIN, I_HYCONV, I_HYW1, I_HYB1, I_HYFREQ, I_HYW2, I_HYB2, I_HYW3,
       I_HYBIAS, I_MLGB, I_MLNG, I_RWMU, I_RWW0, I_RWW2, I_RWA0, I_RWA2, I_RWG2, I_RWKK, I_RWKA, I_RWRK, I_RWLNG, I_RWLNB, I_ATQN, I_ATKN, I_WOUT, I_LN1G, I_LN1B,
       I_W1, I_W2, I_LN2G, I_LN2B };
constexpr size_t O_YP = 0, O_YS = 8388608, O_AK = 16777216, O_AV = O_AK + 4194304, O_MC = O_AV + 4194304, O_MN = O_MC + 4194304, O_MM = O_MN + 65536, O_RS = O_MM + 1024;

__device__ __forceinline__ void wconv_wave(const float* __restrict__ W, int K, int N, int Npad, bf16* WT, int item, float* scr, int lane) {
    const int nblk = Npad / 32, kb = item / nblk, nb = item % nblk, k0 = 64 * kb, n0 = 32 * nb;
    const int n = n0 + (lane & 31);
#pragma unroll 8
    for (int i = 0; i < 32; ++i) { const int kk = 2 * i + (lane >> 5); scr[kk * 33 + (lane & 31)] = (n < N) ? W[(size_t)(k0 + kk) * N + n] : 0.f; }
    LDS_WAIT();
    const int c = lane & 7;
#pragma unroll
    for (int j = 0; j < 4; ++j) { const int nn = (lane >> 3) + 8 * j; const float* s = scr + (8 * c) * 33 + nn;
        u32x4 o; o.x = pk2(s[0 * 33], s[1 * 33]); o.y = pk2(s[2 * 33], s[3 * 33]); o.z = pk2(s[4 * 33], s[5 * 33]); o.w = pk2(s[6 * 33], s[7 * 33]);
        *(u32x4*)(WT + (size_t)(n0 + nn) * K + k0 + 8 * c) = o; }
    LDS_WAIT();
}
__device__ __forceinline__ void wconv_block(const float* W, int K, int N, int Npad, bf16* WT, int it0, int cnt, unsigned char* lds, int wave, int lane) {
    float* scr = (float*)lds + wave * (64 * 33);
    for (int i = wave; i < cnt; i += NWAVE) wconv_wave(W, K, N, Npad, WT, it0 + i, scr, lane);
}

__device__ __forceinline__ void phase0(const KA& A, unsigned char* lds, int tid, int wave, int lane, int bid, int G) {
    unsigned char* ws = A.ws;
    {
        const int nitems = (1024 / 64) * (PINP / 32);
        float* scr = (float*)lds + wave * (64 * 33);
        for (int it = bid * NWAVE + wave; it < nitems; it += G * NWAVE) wconv_wave(A.in(I_WIN), 1024, PIN, PINP, (bf16*)(ws + WS_WIN), it, scr, lane);
    }
    __syncthreads();
    {
        float* sil = (float*)lds;
        float* red = sil + 3 * 1024;
        for (int i = tid; i < 3 * 1024; i += NTHR) { const float c = (i < 1024) ? A.in(I_CCTX)[i] : A.in(I_C)[i - 1024]; sil[i] = c / (1.0f + __expf(-c)); }
        __syncthreads();
        for (int item = bid; item < 4 * 96; item += G) {
            const int l = item / 96, cb = item % 96, col = cb * 64 + lane;
            const float* W = A.in(I_WMOD) + (size_t)l * 1024 * 6144 + col;
            float a0 = 0.f, a1 = 0.f, a2 = 0.f;
            const int kbeg = wave * 128;
#pragma unroll 8
            for (int k = kbeg; k < kbeg + 128; ++k) { const float w = W[(size_t)k * 6144]; a0 += sil[k] * w; a1 += sil[1024 + k] * w; a2 += sil[2048 + k] * w; }
            red[(wave * 3 + 0) * 64 + lane] = a0; red[(wave * 3 + 1) * 64 + lane] = a1; red[(wave * 3 + 2) * 64 + lane] = a2;
            __syncthreads();
            if (tid < 192) { const int c = tid >> 6, ln = tid & 63; float s = 0.f;
#pragma unroll
                for (int w = 0; w < 8; ++w) s += red[(w * 3 + c) * 64 + ln];
                ((float*)(ws + WS_MOD))[(size_t)(l * 3 + c) * 6144 + cb * 64 + ln] = s + A.in(I_BMOD)[l * 6144 + cb * 64 + ln]; }
            __syncthreads();
        }
    }
    if (bid == G - 1) {
        float* rt = (float*)(ws + WS_ROPE);
        for (int i = tid; i < 1024; i += NTHR) { const int pos = i >> 4, f = i & 15; const float inv = exp2f(-(float)f * (13.287712379549449f / 16.0f)), ang = (float)pos * inv;
            rt[i] = cosf(ang); rt[1024 + i] = sinf(ang); }
    }
}

__device__ __forceinline__ int cond_of_row(int m) { return m < NCTX ? 0 : 1 + ((m - NCTX) >> 12); }
__device__ __forceinline__ void phase_mod0(const KA& A, int wave, int lane, int bid, int G) {
    const float* mod = (const float*)(A.ws + WS_MOD);
    bf16* H = (bf16*)(A.ws + WS_H);
    for (int m = bid * NWAVE + wave; m < NTOK; m += G * NWAVE) {
        const float* x = (m < NCTX) ? A.in(I_XP) + (size_t)m * 1024 : A.in(I_XS) + (size_t)(m - NCTX) * 1024;
        const float* md = mod + (size_t)cond_of_row(m) * 6144;
#pragma unroll
        for (int j = 0; j < 4; ++j) { const int c = lane * 4 + 256 * j; const f32x4 v = *(const f32x4*)(x + c), sh = *(const f32x4*)(md + c), sc = *(const f32x4*)(md + 1024 + c);
            const f32x4 h = v * (sc + 1.0f) + sh; u32x2 o; o.x = pk2(h[0], h[1]); o.y = pk2(h[2], h[3]); *(u32x2*)(H + (size_t)m * 1024 + c) = o; }
    }
}
__device__ __forceinline__ void phase_ln(const KA& A, const float* g, const float* b, const float* mdn, int shofs, int wave, int lane, int bid, int G) {
    float* X = A.out; bf16* H = (bf16*)(A.ws + WS_H);
    for (int m = bid * NWAVE + wave; m < NTOK; m += G * NWAVE) {
        float* x = X + (size_t)m * 1024;
        f32x4 v[4]; float s = 0.f;
#pragma unroll
        for (int j = 0; j < 4; ++j) { v[j] = *(const f32x4*)(x + lane * 4 + 256 * j); s += (v[j][0] + v[j][1]) + (v[j][2] + v[j][3]); }
        const float mean = wave_sum(s) * (1.f / 1024.f); float q = 0.f;
#pragma unroll
        for (int j = 0; j < 4; ++j) { v[j] = v[j] - mean; q += (v[j][0] * v[j][0] + v[j][1] * v[j][1]) + (v[j][2] * v[j][2] + v[j][3] * v[j][3]); }
        const float rstd = 1.0f / sqrtf(wave_sum(q) * (1.f / 1024.f) + 1e-5f);
        const float* md = mdn ? mdn + (size_t)cond_of_row(m) * 6144 + shofs : nullptr;
#pragma unroll
        for (int j = 0; j < 4; ++j) { const int c = lane * 4 + 256 * j; const f32x4 y = v[j] * rstd * *(const f32x4*)(g + c) + *(const f32x4*)(b + c);
            *(f32x4*)(x + c) = y;
            if (md) { const f32x4 h = y * (*(const f32x4*)(md + 1024 + c) + 1.0f) + *(const f32x4*)(md + c); u32x2 o; o.x = pk2(h[0], h[1]); o.y = pk2(h[2], h[3]); *(u32x2*)(H + (size_t)m * 1024 + c) = o; } }
    }
}

__device__ __forceinline__ void p2_filter_item(const KA& A, int l, int g, int rb, unsigned char* lds, int tid) {
    const int L = g ? 4096 : 256;
    float* z = (float*)lds;
    float* h1 = z + 64 * 33 + 16;
    float* h2 = h1 + 64 * 64;
    for (int i = tid; i < 64 * 33; i += NTHR) { const int row = i / 33, e = i % 33, idx = rb * 64 + row;
        float v;
        if (e == 0) v = (float)idx / (float)(L - 1);
        else { const int j = (e - 1) & 15; const float band = 1e-4f + (float)j * ((15.0f - 1e-4f) / 15.0f);
            float turns = band * ((float)idx / (float)L); turns -= floorf(turns);
            const float ang = 6.283185307179586f * turns;
            v = (e <= 16) ? cosf(ang) : sinf(ang); }
        z[row * 33 + e] = v; }
    __syncthreads();
    { const int n = tid & 63; const float* w1 = A.in(I_HYW1) + (size_t)l * 33 * 64 + n; const float fr = A.in(I_HYFREQ)[l * 64 + n], b1 = A.in(I_HYB1)[l * 64 + n];
      float w[33];
#pragma unroll
      for (int e = 0; e < 33; ++e) w[e] = w1[e * 64];
      for (int k = 0; k < 8; ++k) { const int row = (tid >> 6) + 8 * k; float s = b1;
#pragma unroll
          for (int e = 0; e < 33; ++e) s += z[row * 33 + e] * w[e];
          h1[row * 64 + n] = sinf(fr * s); } }
    __syncthreads();
    { const int n = tid & 63; const float* w2 = A.in(I_HYW2) + (size_t)l * 64 * 64 + n; const float fr = A.in(I_HYFREQ)[l * 64 + n], b2 = A.in(I_HYB2)[l * 64 + n];
      float w[64];
#pragma unroll
      for (int e = 0; e < 64; ++e) w[e] = w2[e * 64];
      for (int k = 0; k < 8; ++k) { const int row = (tid >> 6) + 8 * k; float s = b2;
#pragma unroll
          for (int e = 0; e < 64; e += 4) { const f32x4 hv = *(const f32x4*)(h1 + row * 64 + e); s += hv[0] * w[e] + hv[1] * w[e + 1] + hv[2] * w[e + 2] + hv[3] * w[e + 3]; }
          h2[row * 64 + n] = sinf(fr * s); } }
    __syncthreads();
    bf16* filt = (bf16*)(A.ws + WS_FILT + (g ? FILT_LAT_OFF : 0));
    float* part = (float*)(A.ws + WS_PART) + (size_t)((g ? 4 : 0) + rb) * 1024;
    const float DMIN = -3.0701134573253940f, DMAX = -15.350567286626970f;
    for (int cc = 0; cc < 2; ++cc) {
        const int col = tid + 512 * cc, f = col >> 9, dir = (col >> 8) & 1, c = col & 255;
        const float* w3 = A.in(I_HYW3) + (size_t)l * 64 * 1024 + col;
        float w[64];
#pragma unroll
        for (int e = 0; e < 64; ++e) w[e] = w3[e * 1024];
        const float delta = fabsf(DMIN + (float)c * ((DMAX - DMIN) / 255.0f));
        bf16* fb = filt + (size_t)(f * 256 + c) * (2 * L);
        float asum = 0.f;
        for (int row = 0; row < 64; ++row) { float s = 0.f;
#pragma unroll
            for (int e = 0; e < 64; e += 4) { const f32x4 hv = *(const f32x4*)(h2 + row * 64 + e); s += hv[0] * w[e] + hv[1] * w[e + 1] + hv[2] * w[e + 2] + hv[3] * w[e + 3]; }
            const int m = rb * 64 + row; const float t = (float)m / (float)(L - 1);
            const float v = s * __expf(-t * delta);
            if (dir == 0) { fb[L + m] = (bf16)f2bf(v); asum += fabsf(v); }
            else if (m >= 1) { fb[L - m] = (bf16)f2bf(v); asum += fabsf(v); }
        }
        if (rb == 0 && dir == 0) fb[0] = 0;
        part[col] = asum;
    }
    __syncthreads();
}

__device__ __forceinline__ void p2_tile_item(const KA& A, int l, int tile, unsigned char* lds, int tid) {
    unsigned char* ws = A.ws;
    const bf16* P = (const bf16*)(ws + WS_P);
    const int m0 = tile * 64, g = m0 >= NCTX, L = g ? 4096 : 256;
    const int seqbase = g ? NCTX + ((m0 - NCTX) & ~4095) : (m0 & ~255), b = g ? (m0 - NCTX) >> 12 : m0 >> 8, t0 = m0 - seqbase;
    bf16* T = (bf16*)lds;
    bf16* VT = T + 64 * 72;
    const int tok = tid >> 3, j8 = tid & 7, m = m0 + tok, t = t0 + tok;
    {
        const bool hp = t > 0, hn = t < L - 1;
        bf16* XT = (bf16*)(ws + WS_XT);
        for (int cb = 0; cb < 12; ++cb) {
            const int col = cb * 64 + j8 * 8;
            const bf16* pr = P + (size_t)m * PINP + col;
            const u32x4 cur = *(const u32x4*)pr;
            u32x4 prv = (u32x4){0, 0, 0, 0}, nxt = (u32x4){0, 0, 0, 0};
            if (hp) prv = *(const u32x4*)(pr - PINP);
            if (hn) nxt = *(const u32x4*)(pr + PINP);
            float a[8], bq[8], c[8]; unpack8(prv, a); unpack8(cur, bq); unpack8(nxt, c);
            const float* cw = A.in(I_HYCONV) + (size_t)l * 3 * 768 + col;
#pragma unroll
            for (int e = 0; e < 8; ++e) { const float o = a[e] * cw[e] + bq[e] * cw[768 + e] + c[e] * cw[1536 + e]; T[(j8 * 8 + e) * 72 + tok] = (bf16)f2bf(o); }
            __syncthreads();
            { const int colr = tid >> 3, tg = tid & 7; const u32x4 v = *(const u32x4*)(T + colr * 72 + tg * 8);
              const int which = cb >> 2, ch = (cb & 3) * 64 + colr;
              *(u32x4*)(XT + ((size_t)which * 256 + ch) * NTOK + m0 + tg * 8) = v; }
            __syncthreads();
        }
    }
    {
        const float* rt = (const float*)(ws + WS_ROPE);
        if (j8 < 6) {
            const int col = C_AT + j8 * 64;
            float x[64];
#pragma unroll
            for (int e = 0; e < 8; ++e) { const u32x4 w = *(const u32x4*)(P + (size_t)m * PINP + col + e * 8); unpack8(w, x + e * 8); }
            float ss = 0.f;
#pragma unroll
            for (int e = 0; e < 64; ++e) ss += x[e] * x[e];
            const float r = 1.0f / sqrtf(ss * (1.f / 64.f) + 1e-6f);
            const float* wn = (j8 < 4 ? A.in(I_ATQN) : A.in(I_ATKN)) + l * 64;
#pragma unroll
            for (int e = 0; e < 64; ++e) x[e] = x[e] * r * wn[e];
            if (g) {
                const int prow = t >> 6, pcol = t & 63;
#pragma unroll
                for (int i = 0; i < 16; ++i) {
                    const float c1 = rt[prow * 16 + i], s1 = rt[1024 + prow * 16 + i], c2 = rt[pcol * 16 + i], s2 = rt[1024 + pcol * 16 + i];
                    const float a1 = x[i], b1 = x[16 + i], a2 = x[32 + i], b2 = x[48 + i];
                    x[i] = a1 * c1 - b1 * s1; x[16 + i] = a1 * s1 + b1 * c1; x[32 + i] = a2 * c2 - b2 * s2; x[48 + i] = a2 * s2 + b2 * c2; }
            }
            if (j8 < 4) {
                bf16* q = (bf16*)(ws + WS_QB) + (size_t)m * 256 + j8 * 64;
#pragma unroll
                for (int e = 0; e < 8; ++e) { u32x4 o; o.x = pk2(x[e * 8] * QSCALE, x[e * 8 + 1] * QSCALE); o.y = pk2(x[e * 8 + 2] * QSCALE, x[e * 8 + 3] * QSCALE);
                    o.z = pk2(x[e * 8 + 4] * QSCALE, x[e * 8 + 5] * QSCALE); o.w = pk2(x[e * 8 + 6] * QSCALE, x[e * 8 + 7] * QSCALE); *(u32x4*)(q + e * 8) = o; }
            } else {
                const int kvh = j8 - 4;
                bf16* kd = g ? (bf16*)(ws + WS_KBL) + ((size_t)(b * 2 + kvh) * 4608 + t) * 64 : (bf16*)(ws + WS_KBC) + ((size_t)(b * 2 + kvh) * 256 + t) * 64;
#pragma unroll
                for (int e = 0; e < 8; ++e) { u32x4 o; o.x = pk2(x[e * 8], x[e * 8 + 1]); o.y = pk2(x[e * 8 + 2], x[e * 8 + 3]); o.z = pk2(x[e * 8 + 4], x[e * 8 + 5]); o.w = pk2(x[e * 8 + 6], x[e * 8 + 7]);
                    *(u32x4*)(kd + e * 8) = o; }
                if (!g) { float* ok = A.out + O_AK + ((((size_t)b * 4 + l) * 256 + t) * 2 + kvh) * 64;
#pragma unroll
                    for (int e = 0; e < 16; ++e) *(f32x4*)(ok + e * 4) = (f32x4){x[e * 4], x[e * 4 + 1], x[e * 4 + 2], x[e * 4 + 3]}; }
            }
        } else {
            const int kvh = j8 - 6, col = C_AT + 384 + kvh * 64;
            float x[64];
#pragma unroll
            for (int e = 0; e < 8; ++e) { const u32x4 w = *(const u32x4*)(P + (size_t)m * PINP + col + e * 8); unpack8(w, x + e * 8); }
            if (!g) { float* ov = A.out + O_AV + ((((size_t)b * 4 + l) * 256 + t) * 2 + kvh) * 64;
#pragma unroll
                for (int e = 0; e < 16; ++e) *(f32x4*)(ov + e * 4) = (f32x4){x[e * 4], x[e * 4 + 1], x[e * 4 + 2], x[e * 4 + 3]}; }
#pragma unroll
            for (int e = 0; e < 64; ++e) VT[(kvh * 64 + e) * 72 + tok] = (bf16)f2bf(x[e]);
        }
        __syncthreads();
        for (int i = tid; i < 1024; i += NTHR) { const int row = i >> 3, tg = i & 7, kvh = row >> 6, d = row & 63;
            const u32x4 v = *(const u32x4*)(VT + row * 72 + tg * 8);
            bf16* vd = g ? (bf16*)(ws + WS_VTL) + ((size_t)(b * 2 + kvh) * 64 + d) * 4608 + t0 + tg * 8 : (bf16*)(ws + WS_VTC) + ((size_t)(b * 2 + kvh) * 64 + d) * 256 + t0 + tg * 8;
            *(u32x4*)vd = v; }
        __syncthreads();
    }
}
__device__ __forceinline__ void p2_cache_item(const KA& A, int l, int item, int tid) {
    const int b = item >> 1, kvh = item & 1;
    const float* ck = A.in(I_CK) + ((size_t)(b * 4 + l) * 512) * 128 + kvh * 64;
    const float* cv = A.in(I_CV) + ((size_t)(b * 4 + l) * 512) * 128 + kvh * 64;
    bf16* kd = (bf16*)(A.ws + WS_KBL) + ((size_t)(b * 2 + kvh) * 4608 + 4096) * 64;
    bf16* vd = (bf16*)(A.ws + WS_VTL) + ((size_t)(b * 2 + kvh) * 64) * 4608 + 4096;
    for (int i = tid; i < 512 * 64; i += NTHR) { const int s = i >> 6, d = i & 63;
        kd[s * 64 + d] = (bf16)f2bf(ck[(size_t)s * 128 + d]);
        vd[(size_t)d * 4608 + s] = (bf16)f2bf(cv[(size_t)s * 128 + d]); }
}
__device__ __forceinline__ void phase2(const KA& A, int l, unsigned char* lds, int tid0, int bid, int G) {
    for (int it = bid; it < 68 + 256 + 4; it += G) {
        int tid = tid0; asm volatile("" : "+v"(tid));
        if (it < 64) p2_filter_item(A, l, 1, it, lds, tid);
        else if (it < 68) p2_filter_item(A, l, 0, it - 64, lds, tid);
        else if (it < 68 + 256) p2_tile_item(A, l, it - 68, lds, tid);
        else p2_cache_item(A, l, it - 68 - 256, tid);
        __syncthreads();
    }
}

#define HY_STEP(NEW, OLD, SS) do { \
    const int B16_ = L + t0 - (SS) - 16; const float* kp_ = KT + B16_ + (B16_ >> 4); \
    _Pragma("unroll") for (int n = 0; n < 15; ++n) NEW[n] = kp_[1 + n]; \
    NEW[15] = kp_[17]; \
    const f32x4 q0_ = *(const f32x4*)(Vb + (SS)), q1_ = *(const f32x4*)(Vb + (SS) + 4), q2_ = *(const f32x4*)(Vb + (SS) + 8), q3_ = *(const f32x4*)(Vb + (SS) + 12); \
    const float vv_[16] = {q0_[0], q0_[1], q0_[2], q0_[3], q1_[0], q1_[1], q1_[2], q1_[3], q2_[0], q2_[1], q2_[2], q2_[3], q3_[0], q3_[1], q3_[2], q3_[3]}; \
    _Pragma("unroll") for (int jj = 0; jj < 16; ++jj) \
    _Pragma("unroll") for (int i = 0; i < 16; ++i) { const int n = 15 + i - jj; y[i] += (n < 16 ? NEW[n < 16 ? n : 0] : OLD[n >= 16 ? n - 16 : 0]) * vv_[jj]; } \
} while (0)

__device__ __forceinline__ void hy_conv_pass(const float* KT, const float* Vb, int L, int t0, float (&y)[16]) {
    float wa[16], wb[16];
    { const int B16 = L + t0; const float* kp = KT + B16 + (B16 >> 4);
#pragma unroll
      for (int j = 0; j < 15; ++j) wb[j] = kp[1 + j];
      wb[15] = 0.f; }
#pragma unroll
    for (int i = 0; i < 16; ++i) y[i] = 0.f;
    for (int S = 0; S < L; S += 32) { HY_STEP(wa, wb, S); HY_STEP(wb, wa, S + 16); }
}
__device__ __forceinline__ void hy_load_taps(const bf16* frow, float* KT, int L, int tid) {
    for (int i = tid * 8; i < 2 * L; i += NTHR * 8) { const u32x4 w = *(const u32x4*)(frow + i); float f[8]; unpack8(w, f); float* d = KT + i + (i >> 4);
#pragma unroll
        for (int e = 0; e < 8; ++e) d[e] = f[e]; }
}
__device__ __forceinline__ void hy_unit(const KA& A, int l, int g, int c, unsigned char* lds, int tid, int lane, int wave) {
    const int L = g ? 4096 : 256, mb = g ? NCTX : 0;
    float* KT = (float*)lds;
    float* V = KT + 8704;
    float* Z = V + 8192;
    float* nrm = Z + 8192;
    const bf16* filt = (const bf16*)(A.ws + WS_FILT + (g ? FILT_LAT_OFF : 0));
    bf16* XT = (bf16*)(A.ws + WS_XT);
    const bf16* vT = XT + (size_t)c * NTOK + mb; const bf16* x1T = XT + ((size_t)256 + c) * NTOK + mb; const bf16* x2T = XT + ((size_t)512 + c) * NTOK + mb;
    hy_load_taps(filt + (size_t)c * (2 * L), KT, L, tid);
    for (int i = tid * 8; i < 8192; i += NTHR * 8) { const u32x4 w = *(const u32x4*)(vT + i); float f[8]; unpack8(w, f);
        *(f32x4*)(V + i) = (f32x4){f[0], f[1], f[2], f[3]}; *(f32x4*)(V + i + 4) = (f32x4){f[4], f[5], f[6], f[7]}; }
    if (wave < 2) { const float* part = (const float*)(A.ws + WS_PART) + (size_t)(g ? 4 : 0) * 1024; const int nrb = g ? 64 : 4;
        float p = 0.f; if (lane < nrb) p = part[(size_t)lane * 1024 + wave * 512 + c] + part[(size_t)lane * 1024 + wave * 512 + 256 + c];
        p = wave_sum(p); if (lane == 0) nrm[wave] = p; }
    __syncthreads();
    const int o0 = tid * 16, bq = o0 / L, t0 = o0 - bq * L;
    float y[16];
    hy_conv_pass(KT, V + bq * L, L, t0, y);
    {
        const float inv = 1.0f / nrm[0], bias = A.in(I_HYBIAS)[l * 512 + c];
        float x1[16]; { const u32x4 w0 = *(const u32x4*)(x1T + o0), w1 = *(const u32x4*)(x1T + o0 + 8); unpack8(w0, x1); unpack8(w1, x1 + 8); }
#pragma unroll
        for (int i = 0; i < 16; ++i) { const float v = V[o0 + i]; Z[o0 + i] = x1[i] * (y[i] * inv + v * bias); }
    }
    __syncthreads();
    hy_load_taps(filt + (size_t)(256 + c) * (2 * L), KT, L, tid);
    __syncthreads();
    hy_conv_pass(KT, Z + bq * L, L, t0, y);
    {
        const float inv = 1.0f / nrm[1], bias = A.in(I_HYBIAS)[l * 512 + 256 + c];
        float x2[16]; { const u32x4 w0 = *(const u32x4*)(x2T + o0), w1 = *(const u32x4*)(x2T + o0 + 8); unpack8(w0, x2); unpack8(w1, x2 + 8); }
        float o[16];
#pragma unroll
        for (int i = 0; i < 16; ++i) { const float z = Z[o0 + i]; o[i] = x2[i] * (y[i] * inv + z * bias); }
        u32x4 w0, w1; w0.x = pk2(o[0], o[1]); w0.y = pk2(o[2], o[3]); w0.z = pk2(o[4], o[5]); w0.w = pk2(o[6], o[7]);
        w1.x = pk2(o[8], o[9]); w1.y = pk2(o[10], o[11]); w1.z = pk2(o[12], o[13]); w1.w = pk2(o[14], o[15]);
        bf16* yT = XT + ((size_t)256 + c) * NTOK + mb; *(u32x4*)(yT + o0) = w0; *(u32x4*)(yT + o0 + 8) = w1;
    }
    __syncthreads();
}

__device__ __forceinline__ int crow(int r, int hi) { return (r & 3) + 8 * (r >> 2) + 4 * hi; }
__device__ __forceinline__ void attn_unit(const KA& A, int g, int b, int kvh, int qt, unsigned char* lds, int tid, int lane, int wave) {
    unsigned char* ws = A.ws;
    const int NK = g ? 4608 : 256, NT = NK / 64;
    const bf16* Kg = g ? (const bf16*)(ws + WS_KBL) + (size_t)(b * 2 + kvh) * 4608 * 64 : (const bf16*)(ws + WS_KBC) + (size_t)(b * 2 + kvh) * 256 * 64;
    const bf16* Vg = g ? (const bf16*)(ws + WS_VTL) + (size_t)(b * 2 + kvh) * 64 * 4608 : (const bf16*)(ws + WS_VTC) + (size_t)(b * 2 + kvh) * 64 * 256;
    const int mrow0 = (g ? NCTX + b * 4096 : b * 256) + qt * 128;
    const int hh = wave & 1, tb = wave >> 1, head = kvh * 2 + hh, r32 = lane & 31, hi = lane >> 5;
    unsigned char* Kl = lds;
    unsigned char* Vl = lds + 2 * 9216;
    bf16x8 qf[4];
    { const bf16* q = (const bf16*)(ws + WS_QB) + (size_t)(mrow0 + tb * 32 + r32) * 256 + head * 64 + hi * 8;
#pragma unroll
      for (int s = 0; s < 4; ++s) qf[s] = *(const bf16x8*)(q + s * 16); }
    const int lrow = tid >> 3, lch = tid & 7;
    u32x4 kreg, vreg;
    kreg = *(const u32x4*)(Kg + (size_t)lrow * 64 + lch * 8);
    vreg = *(const u32x4*)(Vg + (size_t)lrow * NK + lch * 8);
    *(u32x4*)(Kl + lrow * 144 + lch * 16) = kreg;
    *(u32x2*)(Vl + lrow * 136 + lch * 16) = (u32x2){vreg.x, vreg.y}; *(u32x2*)(Vl + lrow * 136 + lch * 16 + 8) = (u32x2){vreg.z, vreg.w};
    __syncthreads();
    f32x16 o0 = {}, o1 = {};
    float mrun = -1e30f, lsum = 0.f;
    for (int j = 0; j < NT; ++j) {
        const int cur = j & 1;
        if (j + 1 < NT) { kreg = *(const u32x4*)(Kg + (size_t)((j + 1) * 64 + lrow) * 64 + lch * 8); vreg = *(const u32x4*)(Vg + (size_t)lrow * NK + (j + 1) * 64 + lch * 8); }
        const unsigned char* Kc = Kl + cur * 9216; const unsigned char* Vc = Vl + cur * 8704;
        f32x16 s0 = {}, s1 = {};
#pragma unroll
        for (int s = 0; s < 4; ++s) {
            const bf16x8 k0 = *(const bf16x8*)(Kc + r32 * 144 + s * 32 + hi * 16);
            const bf16x8 k1 = *(const bf16x8*)(Kc + (32 + r32) * 144 + s * 32 + hi * 16);
            s0 = __builtin_amdgcn_mfma_f32_32x32x16_bf16(k0, qf[s], s0, 0, 0, 0);
            s1 = __builtin_amdgcn_mfma_f32_32x32x16_bf16(k1, qf[s], s1, 0, 0, 0);
        }
        float tm = fmaxf(s0[0], s1[0]);
#pragma unroll
        for (int r = 1; r < 16; ++r) tm = fmaxf(tm, fmaxf(s0[r], s1[r]));
        tm = fmaxf(tm, __shfl_xor(tm, 32));
        const float mnew = fmaxf(mrun, tm), alpha = __builtin_amdgcn_exp2f(mrun - mnew);
        mrun = mnew;
        float ps = 0.f;
#pragma unroll
        for (int r = 0; r < 16; ++r) { s0[r] = __builtin_amdgcn_exp2f(s0[r] - mnew); s1[r] = __builtin_amdgcn_exp2f(s1[r] - mnew); ps += s0[r] + s1[r]; }
        lsum = lsum * alpha + ps;
#pragma unroll
        for (int r = 0; r < 16; ++r) { o0[r] *= alpha; o1[r] *= alpha; }
#pragma unroll
        for (int ks = 0; ks < 4; ++ks) {
            bf16x8 pf;
            { u32x4 w; const int rb = 8 * (ks & 1);
              if (ks < 2) { w.x = pk2(s0[rb], s0[rb + 1]); w.y = pk2(s0[rb + 2], s0[rb + 3]); w.z = pk2(s0[rb + 4], s0[rb + 5]); w.w = pk2(s0[rb + 6], s0[rb + 7]); }
              else        { w.x = pk2(s1[rb], s1[rb + 1]); w.y = pk2(s1[rb + 2], s1[rb + 3]); w.z = pk2(s1[rb + 4], s1[rb + 5]); w.w = pk2(s1[rb + 6], s1[rb + 7]); }
              pf = __builtin_bit_cast(bf16x8, w); }
            const int kb = (16 * ks + 4 * hi) * 2;
            { const u32x2 a = *(const u32x2*)(Vc + r32 * 136 + kb), bq = *(const u32x2*)(Vc + r32 * 136 + kb + 16);
              const bf16x8 vf = __builtin_bit_cast(bf16x8, (u32x4){a.x, a.y, bq.x, bq.y});
              o0 = __builtin_amdgcn_mfma_f32_32x32x16_bf16(vf, pf, o0, 0, 0, 0); }
            { const u32x2 a = *(const u32x2*)(Vc + (32 + r32) * 136 + kb), bq = *(const u32x2*)(Vc + (32 + r32) * 136 + kb + 16);
              const bf16x8 vf = __builtin_bit_cast(bf16x8, (u32x4){a.x, a.y, bq.x, bq.y});
              o1 = __builtin_amdgcn_mfma_f32_32x32x16_bf16(vf, pf, o1, 0, 0, 0); }
        }
        if (j + 1 < NT) { unsigned char* Kn = Kl + (cur ^ 1) * 9216; unsigned char* Vn = Vl + (cur ^ 1) * 8704;
            *(u32x4*)(Kn + lrow * 144 + lch * 16) = kreg;
            *(u32x2*)(Vn + lrow * 136 + lch * 16) = (u32x2){vreg.x, vreg.y}; *(u32x2*)(Vn + lrow * 136 + lch * 16 + 8) = (u32x2){vreg.z, vreg.w}; }
        __syncthreads();
    }
    lsum += __shfl_xor(lsum, 32);
    const float inv = 1.0f / lsum;
    bf16* yo = (bf16*)(ws + WS_YC) + (size_t)(mrow0 + tb * 32 + r32) * 1024 + 768 + head * 64;
#pragma unroll
    for (int rg = 0; rg < 4; ++rg) { const int d = 8 * rg + 4 * hi;
        u32x2 w; w.x = pk2(o0[4 * rg] * inv, o0[4 * rg + 1] * inv); w.y = pk2(o0[4 * rg + 2] * inv, o0[4 * rg + 3] * inv); *(u32x2*)(yo + d) = w;
        u32x2 w2; w2.x = pk2(o1[4 * rg] * inv, o1[4 * rg + 1] * inv); w2.y = pk2(o1[4 * rg + 2] * inv, o1[4 * rg + 3] * inv); *(u32x2*)(yo + 32 + d) = w2; }
}

namespace hy2 {
constexpr int CS = 8480;
constexpr int OFF_IMG = 8 * CS;
constexpr int IMG_MAX = 54720;
constexpr int OFF_RAW = OFF_IMG + IMG_MAX;
constexpr int OFF_NRM = OFF_RAW + 16384;
constexpr int OFF_R = 32768;
}
__device__ __forceinline__ void hy_unit_mfma(const KA& A, int l, int g, int c, unsigned char* lds, int tid, int lane, int wave) {
    using namespace hy2;
    const int nb = g ? 64 : 4, L = nb * 64, mb = g ? NCTX : 0;
    const int IMG_B = (3 * nb - 2) * 144;
    unsigned char* img = lds + OFF_IMG; bf16* raw = (bf16*)(lds + OFF_RAW); float* nrm = (float*)(lds + OFF_NRM); float* R = (float*)(lds + OFF_R);
    const bf16* filt = (const bf16*)(A.ws + WS_FILT + (g ? FILT_LAT_OFF : 0));
    const bf16* XT = (const bf16*)(A.ws + WS_XT);
    const bf16* vT = XT + (size_t)c * NTOK + mb; const bf16* x1T = XT + ((size_t)256 + c) * NTOK + mb; const bf16* x2T = XT + ((size_t)512 + c) * NTOK + mb;
    bf16* yT = (bf16*)(A.ws + WS_YT) + (size_t)c * NTOK + mb;
    for (int i = tid; i < IMG_MAX / 16; i += NTHR) *(u32x4*)(img + i * 16) = (u32x4){0u, 0u, 0u, 0u};
    if (wave < 2) { const float* part = (const float*)(A.ws + WS_PART) + (size_t)(g ? 4 : 0) * 1024; const int nrb = g ? 64 : 4;
        float p = 0.f; if (lane < nrb) p = part[(size_t)lane * 1024 + wave * 512 + c] + part[(size_t)lane * 1024 + wave * 512 + 256 + c];
        p = wave_sum(p); if (lane == 0) nrm[wave] = p; }
    __syncthreads();
    for (int ch = tid; ch < 1024; ch += NTHR) { const int o = ch * 8, bt = o / L, t = o - bt * L;
        *(u32x4*)(img + bt * IMG_B + ((t >> 6) + nb - 1) * 144 + (t & 63) * 2) = *(const u32x4*)(vT + o); }
    const int nh = wave & 1, dq = wave >> 1, r = lane & 31, h = lane >> 5;
    const int aoff0 = (r & 7) * CS + ((r >> 3) - h) * 16;
    int boff[2];
#pragma unroll
    for (int t2 = 0; t2 < 2; ++t2) { const int n = (2 * nh + t2) * 32 + r; const int bt = g ? (n >> 6) : (n >> 2), i = g ? (n & 63) : (n & 3);
        boff[t2] = OFF_IMG + bt * IMG_B + (i + nb - 1) * 144 + h * 16; }
    const int o0 = tid * 16, ebt = o0 / L, et0 = o0 - ebt * L, ei = et0 >> 6, ea0 = et0 & 63, en = g ? ebt * 64 + ei : ebt * 4 + ei;
    unsigned char* eimg = img + ebt * IMG_B + (ei + nb - 1) * 144 + ea0 * 2;
    for (int f = 0; f < 2; ++f) {
        __syncthreads();
        { const bf16* frow = filt + (size_t)(f * 256 + c) * (2 * L); for (int i = tid * 8; i < 2 * L; i += NTHR * 8) *(u32x4*)(raw + i) = *(const u32x4*)(frow + i); }
        f32x16 acc[2][2];
#pragma unroll
        for (int a = 0; a < 2; ++a)
#pragma unroll
            for (int b = 0; b < 2; ++b) acc[a][b] = (f32x16){};
#pragma unroll 1
        for (int H = 0; H < 2; ++H) {
            __syncthreads();
            const int m_off = H ? 7 : 8 * (nb - 1) + 7, nch = H ? 8 * (nb - 1) + 15 : 8 * (nb - 1) + 7;
            for (int ci = tid; ci < 8 * nch; ci += NTHR) { const int s = ci / nch, mi = ci - s * nch, e0 = L + 8 * (mi - m_off) + s;
                unsigned w[4];
#pragma unroll
                for (int j2 = 0; j2 < 4; ++j2) { const int i0 = e0 - 2 * j2, i1 = i0 - 1;
                    const unsigned lo = (i0 >= 0 && i0 < 2 * L) ? raw[i0] : 0u, hi = (i1 >= 0 && i1 < 2 * L) ? raw[i1] : 0u; w[j2] = lo | (hi << 16); }
                *(u32x4*)(lds + s * CS + mi * 16) = (u32x4){w[0], w[1], w[2], w[3]}; }
            __syncthreads();
            const int dlo = g ? 32 * nh - 63 : -1000, dhi = g ? 32 * nh + 31 : 1000;
#pragma unroll 1
            for (int dd = dq; dd < nb; dd += 4) {
                const int d = H ? dd : -1 - dd;
                if (H == 0 && dd >= nb - 1) break;
                if (d < dlo || d > dhi) continue;
                const unsigned char* ap = lds + aoff0 + (m_off + 8 * d) * 16;
                const unsigned char* bp0 = lds + boff[0] - d * 144; const unsigned char* bp1 = lds + boff[1] - d * 144;
#pragma unroll
                for (int q = 0; q < 4; ++q) {
                    const bf16x8 a0 = *(const bf16x8*)(ap - q * 32), a1 = *(const bf16x8*)(ap - q * 32 + 64);
                    const bf16x8 b0 = *(const bf16x8*)(bp0 + q * 32), b1 = *(const bf16x8*)(bp1 + q * 32);
                    acc[0][0] = __builtin_amdgcn_mfma_f32_32x32x16_bf16(a0, b0, acc[0][0], 0, 0, 0);
                    acc[0][1] = __builtin_amdgcn_mfma_f32_32x32x16_bf16(a0, b1, acc[0][1], 0, 0, 0);
                    acc[1][0] = __builtin_amdgcn_mfma_f32_32x32x16_bf16(a1, b0, acc[1][0], 0, 0, 0);
                    acc[1][1] = __builtin_amdgcn_mfma_f32_32x32x16_bf16(a1, b1, acc[1][1], 0, 0, 0);
                }
            }
        }
        __syncthreads();
        float* dump = (float*)lds;
        if (dq >= 2) { float* dp = dump + ((dq - 2) * 2 + nh) * 4096 + lane;
#pragma unroll
            for (int a = 0; a < 2; ++a)
#pragma unroll
                for (int b = 0; b < 2; ++b)
#pragma unroll
                    for (int e = 0; e < 16; ++e) dp[((a * 2 + b) * 16 + e) * 64] = acc[a][b][e]; }
        __syncthreads();
        if (dq < 2) { const float* dp = dump + (dq * 2 + nh) * 4096 + lane;
#pragma unroll
            for (int a = 0; a < 2; ++a)
#pragma unroll
                for (int b = 0; b < 2; ++b)
#pragma unroll
                    for (int e = 0; e < 16; ++e) acc[a][b][e] += dp[((a * 2 + b) * 16 + e) * 64]; }
        __syncthreads();
        if (dq == 1) { float* dp = dump + nh * 4096 + lane;
#pragma unroll
            for (int a = 0; a < 2; ++a)
#pragma unroll
                for (int b = 0; b < 2; ++b)
#pragma unroll
                    for (int e = 0; e < 16; ++e) dp[((a * 2 + b) * 16 + e) * 64] = acc[a][b][e]; }
        __syncthreads();
        if (dq == 0) { const float* dp = dump + nh * 4096 + lane;
#pragma unroll
            for (int a = 0; a < 2; ++a)
#pragma unroll
                for (int b = 0; b < 2; ++b) { const int n = (2 * nh + b) * 32 + r;
#pragma unroll
                    for (int rg = 0; rg < 4; ++rg) { f32x4 v4;
#pragma unroll
                        for (int e = 0; e < 4; ++e) v4[e] = acc[a][b][rg * 4 + e] + dp[((a * 2 + b) * 16 + rg * 4 + e) * 64];
                        *(f32x4*)(R + n * 68 + 32 * a + 8 * rg + 4 * h) = v4; } } }
        __syncthreads();
        {
            const float inv = 1.0f / nrm[f], bias = A.in(I_HYBIAS)[l * 512 + f * 256 + c];
            float y[16], xg[16], vz[16];
#pragma unroll
            for (int e4 = 0; e4 < 4; ++e4) { const f32x4 t = *(const f32x4*)(R + en * 68 + ea0 + 4 * e4); y[4 * e4] = t[0]; y[4 * e4 + 1] = t[1]; y[4 * e4 + 2] = t[2]; y[4 * e4 + 3] = t[3]; }
            { const bf16* xs = (f ? x2T : x1T) + o0; unpack8(*(const u32x4*)xs, xg); unpack8(*(const u32x4*)(xs + 8), xg + 8); }
            unpack8(*(const u32x4*)eimg, vz); unpack8(*(const u32x4*)(eimg + 16), vz + 8);
            float o[16];
#pragma unroll
            for (int e = 0; e < 16; ++e) o[e] = xg[e] * (y[e] * inv + vz[e] * bias);
            u32x4 w0, w1; w0.x = pk2(o[0], o[1]); w0.y = pk2(o[2], o[3]); w0.z = pk2(o[4], o[5]); w0.w = pk2(o[6], o[7]);
            w1.x = pk2(o[8], o[9]); w1.y = pk2(o[10], o[11]); w1.z = pk2(o[12], o[13]); w1.w = pk2(o[14], o[15]);
            if (f == 0) { *(u32x4*)eimg = w0; *(u32x4*)(eimg + 16) = w1; }
            else { *(u32x4*)(yT + o0) = w0; *(u32x4*)(yT + o0 + 8) = w1; }
        }
    }
    __syncthreads();
}

struct ChunkItem { int g, b, h, dir, c, L, nc, seqbase; };
__device__ __forceinline__ ChunkItem decode_item(int it) {
    ChunkItem x;
    if (it < 512) { const int ch = it >> 1; x.g = 0; x.c = it & 1; x.b = ch >> 3; x.h = (ch >> 1) & 3; x.dir = ch & 1; x.L = 256; x.nc = 2; x.seqbase = x.b * 256; }
    else { const int i2 = it - 512, ch = i2 >> 5; x.g = 1; x.c = i2 & 31; x.b = ch >> 3; x.h = (ch >> 1) & 3; x.dir = ch & 1; x.L = 4096; x.nc = 32; x.seqbase = NCTX + x.b * 4096; }
    return x;
}
__device__ __forceinline__ int item_of(int g, int b, int h, int dir, int c) { const int ch = (b * 4 + h) * 2 + dir; return g ? 512 + ch * 32 + c : ch * 2 + c; }

__device__ __forceinline__ void ml_scan128(const float* li, const float* lf, float* bcum, float* av, float* pm, int lane) {
    const float x0 = lf[2 * lane], x1 = lf[2 * lane + 1];
    float s = x0 + x1;
#pragma unroll
    for (int o = 1; o < 64; o <<= 1) { const float t = __shfl_up(s, o); if (lane >= o) s += t; }
    const float ex = s - (x0 + x1);
    const float b0 = ex + x0, b1 = ex + x0 + x1;
    const float a0 = li[2 * lane] - b0, a1 = li[2 * lane + 1] - b1;
    float mx = fmaxf(a0, a1);
#pragma unroll
    for (int o = 1; o < 64; o <<= 1) { const float t = __shfl_up(mx, o); if (lane >= o) mx = fmaxf(mx, t); }
    float pe = __shfl_up(mx, 1); if (lane == 0) pe = -INFINITY;
    bcum[2 * lane] = b0; bcum[2 * lane + 1] = b1; av[2 * lane] = a0; av[2 * lane + 1] = a1;
    pm[2 * lane] = fmaxf(pe, a0); pm[2 * lane + 1] = fmaxf(pe, fmaxf(a0, a1));
}
__device__ __forceinline__ void ml_load_gates(const KA& A, int l, const ChunkItem& x, float* li, float* lf, int tid) {
    if (tid < 128) { const int tk = x.dir ? x.L - 1 - (x.c * 128 + tid) : x.c * 128 + tid; const bf16* p = (const bf16*)(A.ws + WS_P) + (size_t)(x.seqbase + tk) * PINP + C_MLG + x.dir * 8 + x.h;
        const float* gb = A.in(I_MLGB) + l * 16 + x.dir * 8 + x.h;
        li[tid] = bf2f(p[0]) + gb[0]; lf[tid] = logsigmoidf_(bf2f(p[4]) + gb[4]); }
}

__device__ __forceinline__ void ml_local_item(const KA& A, int l, int it, unsigned char* lds, int tid, int lane, int wave) {
    const ChunkItem x = decode_item(it);
    float* kf = (float*)lds;
    float* vf = kf + 128 * 64;
    float* li = vf + 128 * 64; float* lf = li + 128; float* bc = lf + 128; float* av = bc + 128; float* pm = av + 128; float* wk = pm + 128;
    const bf16* P = (const bf16*)(A.ws + WS_P);
    { const int row = tid >> 2, q4 = tid & 3; const int tk = x.dir ? x.L - 1 - (x.c * 128 + row) : x.c * 128 + row;
      const bf16* pr = P + (size_t)(x.seqbase + tk) * PINP + C_ML + x.h * 64 + q4 * 16;
      float f[8];
      unpack8(*(const u32x4*)(pr + 256), f); *(f32x4*)(kf + row * 64 + q4 * 16) = (f32x4){f[0], f[1], f[2], f[3]}; *(f32x4*)(kf + row * 64 + q4 * 16 + 4) = (f32x4){f[4], f[5], f[6], f[7]};
      unpack8(*(const u32x4*)(pr + 256 + 8), f); *(f32x4*)(kf + row * 64 + q4 * 16 + 8) = (f32x4){f[0], f[1], f[2], f[3]}; *(f32x4*)(kf + row * 64 + q4 * 16 + 12) = (f32x4){f[4], f[5], f[6], f[7]};
      unpack8(*(const u32x4*)(pr + 512), f); *(f32x4*)(vf + row * 64 + q4 * 16) = (f32x4){f[0], f[1], f[2], f[3]}; *(f32x4*)(vf + row * 64 + q4 * 16 + 4) = (f32x4){f[4], f[5], f[6], f[7]};
      unpack8(*(const u32x4*)(pr + 512 + 8), f); *(f32x4*)(vf + row * 64 + q4 * 16 + 8) = (f32x4){f[0], f[1], f[2], f[3]}; *(f32x4*)(vf + row * 64 + q4 * 16 + 12) = (f32x4){f[4], f[5], f[6], f[7]}; }
    ml_load_gates(A, l, x, li, lf, tid);
    __syncthreads();
    if (wave == 0) ml_scan128(li, lf, bc, av, pm, lane);
    __syncthreads();
    const float pmax = pm[127];
    if (tid < 128) wk[tid] = __expf(av[tid] - pmax);
    __syncthreads();
    const int d = tid >> 3, eg = tid & 7;
    float acc[8] = {0.f, 0.f, 0.f, 0.f, 0.f, 0.f, 0.f, 0.f}, nacc = 0.f;
    for (int s = 0; s < 128; ++s) { const float kw = kf[s * 64 + d] * wk[s]; const f32x4 v0 = *(const f32x4*)(vf + s * 64 + eg * 8), v1 = *(const f32x4*)(vf + s * 64 + eg * 8 + 4);
        nacc += kw;
        acc[0] += kw * v0[0]; acc[1] += kw * v0[1]; acc[2] += kw * v0[2]; acc[3] += kw * v0[3]; acc[4] += kw * v1[0]; acc[5] += kw * v1[1]; acc[6] += kw * v1[2]; acc[7] += kw * v1[3]; }
    float* o = (float*)(A.ws + WS_MLS) + (size_t)it * MLS_STRIDE;
    *(f32x4*)(o + d * 64 + eg * 8) = (f32x4){acc[0], acc[1], acc[2], acc[3]}; *(f32x4*)(o + d * 64 + eg * 8 + 4) = (f32x4){acc[4], acc[5], acc[6], acc[7]};
    if (eg == 0) o[4096 + d] = nacc;
    if (tid == 0) { o[4160] = pmax; o[4161] = bc[127]; }
    __syncthreads();
}

__device__ __forceinline__ void ml_scan_chain(const KA& A, int l, int ch, int tid) {
    const int g = ch >= 256, cl = g ? ch - 256 : ch, b = cl >> 3, h = (cl >> 1) & 3, dir = cl & 1, nc = g ? 32 : 2;
    const size_t sidx = (((size_t)(b * 4 + l) * 2 + dir) * 4 + h);
    float C[8], n = 0.f, m = 0.f;
#pragma unroll
    for (int e = 0; e < 8; ++e) C[e] = 0.f;
    if (g) { const float* c0 = A.in(I_MLC) + sidx * 4096 + tid * 8;
#pragma unroll
        for (int e = 0; e < 8; ++e) C[e] = c0[e];
        if (tid < 64) n = A.in(I_MLN)[sidx * 64 + tid];
        m = A.in(I_MLM)[sidx]; }
    for (int c = 0; c < nc; ++c) {
        float* o = (float*)(A.ws + WS_MLS) + (size_t)item_of(g, b, h, dir, c) * MLS_STRIDE;
        float cl8[8];
#pragma unroll
        for (int e = 0; e < 8; ++e) cl8[e] = o[tid * 8 + e];
        const float nl = tid < 64 ? o[4096 + tid] : 0.f, pmax = o[4160], bl = o[4161];
        __syncthreads();
#pragma unroll
        for (int e = 0; e < 8; ++e) o[tid * 8 + e] = C[e];
        if (tid < 64) o[4096 + tid] = n;
        if (tid == 0) o[4162] = m;
        const float Mx = fmaxf(m, pmax), dec = __expf(m - Mx), sc = __expf(pmax - Mx);
#pragma unroll
        for (int e = 0; e < 8; ++e) C[e] = dec * C[e] + sc * cl8[e];
        n = dec * n + sc * nl; m = bl + Mx;
    }
    if (!g) { float* oc = A.out + O_MC + sidx * 4096 + tid * 8;
#pragma unroll
        for (int e = 0; e < 8; ++e) oc[e] = C[e];
        if (tid < 64) A.out[O_MN + sidx * 64 + tid] = n;
        if (tid == 0) A.out[O_MM + sidx] = m; }
}

__device__ __forceinline__ void ml_out_item(const KA& A, int l, int item, unsigned char* lds, int tid, int lane, int wave) {
    int g, b, h, tc, L, nc, seqbase;
    if (item < 256) { g = 0; tc = item & 1; const int bh = item >> 1; b = bh >> 2; h = bh & 3; L = 256; nc = 2; seqbase = b * 256; }
    else { const int i2 = item - 256; g = 1; tc = i2 & 31; const int bh = i2 >> 5; b = bh >> 2; h = bh & 3; L = 4096; nc = 32; seqbase = NCTX + b * 4096; }
    bf16* qs = (bf16*)lds;
    bf16* ks = qs + 128 * 72;
    bf16* vs = ks + 128 * 72;
    float* S = (float*)(vs + 128 * 72);
    float* Cs = S + 128 * 132;
    float* nv = Cs + 4096;
    float* li = nv + 64; float* lf = li + 128; float* bc = lf + 128; float* av = bc + 128; float* pm = av + 128;
    float* Mv = pm + 128; float* win = Mv + 128; float* flo = win + 128;
    const bf16* P = (const bf16*)(A.ws + WS_P);
    const int jr = tid >> 4, ec = tid & 15;
    float hacc[4][4];
#pragma unroll
    for (int i = 0; i < 4; ++i)
#pragma unroll
        for (int e = 0; e < 4; ++e) hacc[i][e] = 0.f;
    for (int dir = 0; dir < 2; ++dir) {
        ChunkItem x; x.g = g; x.b = b; x.h = h; x.dir = dir; x.c = dir ? nc - 1 - tc : tc; x.L = L; x.nc = nc; x.seqbase = seqbase;
        const float* st = (const float*)(A.ws + WS_MLS) + (size_t)item_of(g, b, h, dir, x.c) * MLS_STRIDE;
        __syncthreads();
        { const int row = tid >> 2, q4 = tid & 3; const int tk = dir ? L - 1 - (x.c * 128 + row) : x.c * 128 + row;
          const bf16* pr = P + (size_t)(seqbase + tk) * PINP + C_ML + h * 64 + q4 * 16;
          u32x4 w0 = *(const u32x4*)pr, w1 = *(const u32x4*)(pr + 8);
          { float f[8]; unpack8(w0, f); w0.x = pk2(f[0] * 0.125f, f[1] * 0.125f); w0.y = pk2(f[2] * 0.125f, f[3] * 0.125f); w0.z = pk2(f[4] * 0.125f, f[5] * 0.125f); w0.w = pk2(f[6] * 0.125f, f[7] * 0.125f);
            unpack8(w1, f); w1.x = pk2(f[0] * 0.125f, f[1] * 0.125f); w1.y = pk2(f[2] * 0.125f, f[3] * 0.125f); w1.z = pk2(f[4] * 0.125f, f[5] * 0.125f); w1.w = pk2(f[6] * 0.125f, f[7] * 0.125f); }
          *(u32x4*)(qs + row * 72 + q4 * 16) = w0; *(u32x4*)(qs + row * 72 + q4 * 16 + 8) = w1;
          *(u32x4*)(ks + row * 72 + q4 * 16) = *(const u32x4*)(pr + 256); *(u32x4*)(ks + row * 72 + q4 * 16 + 8) = *(const u32x4*)(pr + 256 + 8);
          *(u32x4*)(vs + row * 72 + q4 * 16) = *(const u32x4*)(pr + 512); *(u32x4*)(vs + row * 72 + q4 * 16 + 8) = *(const u32x4*)(pr + 512 + 8); }
        for (int i = tid; i < 4096; i += NTHR) Cs[i] = st[i];
        if (tid < 64) nv[tid] = st[4096 + tid];
        ml_load_gates(A, l, x, li, lf, tid);
        __syncthreads();
        if (wave == 0) ml_scan128(li, lf, bc, av, pm, lane);
        __syncthreads();
        const float m_in = st[4162];
        if (tid < 128) { const float Mx = fmaxf(m_in, pm[tid]); Mv[tid] = Mx; win[tid] = __expf(m_in - Mx); flo[tid] = __expf(-(bc[tid] + Mx)); }
        __syncthreads();
        { const int tb = tid >> 4, sb = tid & 15;
          float acc[4][8];
#pragma unroll
          for (int i = 0; i < 4; ++i)
#pragma unroll
              for (int k = 0; k < 8; ++k) acc[i][k] = 0.f;
#pragma unroll 1
          for (int dc = 0; dc < 8; ++dc) {
              float qf[4][8], kf[8];
#pragma unroll
              for (int i = 0; i < 4; ++i) unpack8(*(const u32x4*)(qs + (tb + 32 * i) * 72 + dc * 8), qf[i]);
#pragma unroll
              for (int k = 0; k < 8; ++k) { unpack8(*(const u32x4*)(ks + (sb + 16 * k) * 72 + dc * 8), kf);
#pragma unroll
                  for (int i = 0; i < 4; ++i)
#pragma unroll
                      for (int e = 0; e < 8; ++e) acc[i][k] += qf[i][e] * kf[e]; }
          }
#pragma unroll
          for (int i = 0; i < 4; ++i) { const int t = tb + 32 * i; const float Mx = Mv[t];
#pragma unroll
              for (int k = 0; k < 8; ++k) { const int s = sb + 16 * k; S[t * 132 + s] = (s <= t) ? acc[i][k] * __expf(av[s] - Mx) : 0.f; } }
        }
        __syncthreads();
#pragma unroll 1
        for (int i = 0; i < 4; ++i) {
            const int j = jr + 32 * i, t = dir ? 127 - j : j;
            float num[4] = {0.f, 0.f, 0.f, 0.f}, den = 0.f;
#pragma unroll 2
            for (int s = 0; s < 128; s += 4) { const f32x4 sv = *(const f32x4*)(S + t * 132 + s);
#pragma unroll
                for (int u = 0; u < 4; ++u) { const u32x2 vw = *(const u32x2*)(vs + (s + u) * 72 + ec * 4); const float sc = sv[u];
                    den += sc; num[0] += sc * lo16(vw.x); num[1] += sc * hi16(vw.x); num[2] += sc * lo16(vw.y); num[3] += sc * hi16(vw.y); } }
            float qc[4] = {0.f, 0.f, 0.f, 0.f}, qn = 0.f;
#pragma unroll 1
            for (int d8 = 0; d8 < 8; ++d8) { float qf[8]; unpack8(*(const u32x4*)(qs + t * 72 + d8 * 8), qf);
#pragma unroll
                for (int e = 0; e < 8; ++e) { const f32x4 cv = *(const f32x4*)(Cs + (d8 * 8 + e) * 64 + ec * 4); qc[0] += qf[e] * cv[0]; qc[1] += qf[e] * cv[1]; qc[2] += qf[e] * cv[2]; qc[3] += qf[e] * cv[3]; qn += qf[e] * nv[d8 * 8 + e]; } }
            const float w = win[t]; den += w * qn;
            const float dd = 1.0f / fmaxf(fabsf(den), flo[t]);
#pragma unroll
            for (int e = 0; e < 4; ++e) hacc[i][e] += (num[e] + w * qc[e]) * dd;
        }
    }
    const float* ng = A.in(I_MLNG) + l * 256 + h * 64 + ec * 4;
#pragma unroll
    for (int i = 0; i < 4; ++i) {
        const int j = jr + 32 * i, m = seqbase + tc * 128 + j;
        float s = (hacc[i][0] + hacc[i][1]) + (hacc[i][2] + hacc[i][3]);
        s += __shfl_xor(s, 1); s += __shfl_xor(s, 2); s += __shfl_xor(s, 4); s += __shfl_xor(s, 8);
        const float mean = s * (1.f / 64.f);
        float q = 0.f;
#pragma unroll
        for (int e = 0; e < 4; ++e) { const float dl = hacc[i][e] - mean; q += dl * dl; }
        q += __shfl_xor(q, 1); q += __shfl_xor(q, 2); q += __shfl_xor(q, 4); q += __shfl_xor(q, 8);
        const float rstd = 1.0f / sqrtf(q * (1.f / 64.f) + 1e-6f);
        const u32x2 ow = *(const u32x2*)(P + (size_t)m * PINP + C_ML + 768 + h * 64 + ec * 4);
        const float og[4] = {lo16(ow.x), hi16(ow.x), lo16(ow.y), hi16(ow.y)};
        float r[4];
#pragma unroll
        for (int e = 0; e < 4; ++e) r[e] = (hacc[i][e] - mean) * rstd * ng[e] * sigmoidf_(og[e]);
        u32x2 w; w.x = pk2(r[0], r[1]); w.y = pk2(r[2], r[3]);
        *(u32x2*)((bf16*)(A.ws + WS_YC) + (size_t)m * 1024 + 256 + h * 64 + ec * 4) = w;
    }
    __syncthreads();
}

__device__ __forceinline__ float rdl(float v, int l) { return __uint_as_float((unsigned)__builtin_amdgcn_readlane((int)__float_as_uint(v), l)); }
__device__ __forceinline__ float rw_shift(const bf16* P, const float* mu, int seqbase, int L, int tk, int col) {
    const bf16* p = P + (size_t)(seqbase + tk) * PINP + C_RW + col;
    const float c = bf2f(p[0]);
    const float pv = tk > 0 ? bf2f(p[-PINP]) : 0.f, nx = tk < L - 1 ? bf2f(p[PINP]) : 0.f;
    return c + mu[col] * (0.5f * (pv + nx) - c);
}

__device__ __forceinline__ void rw_local_block(const KA& A, int l, int r, unsigned char* lds, int tid, int lane, int wave) {
    const int hd = r >> 4, h = hd >> 1, dir = hd & 1, j = (r & 15) * 8 + wave;
    ChunkItem x; x.h = h; x.dir = dir;
    if (j < 64) { x.g = 0; x.b = j >> 1; x.c = j & 1; x.L = 256; x.nc = 2; x.seqbase = x.b * 256; }
    else { x.g = 1; x.b = (j - 64) >> 5; x.c = (j - 64) & 31; x.L = 4096; x.nc = 32; x.seqbase = NCTX + x.b * 4096; }
    const int it = item_of(x.g, x.b, h, dir, x.c);
    float* wl = (float*)lds + wave * 3072;
    float* w2s = (float*)lds + 24576;
    float* a2s = w2s + 4096;
    { const float* w2g = A.in(I_RWW2) + ((size_t)(l * 2 + dir) * 64) * 256 + h * 64; const float* a2g = A.in(I_RWA2) + ((size_t)(l * 2 + dir) * 64) * 256 + h * 64;
      for (int i = tid; i < 1024; i += NTHR) { const int row = i >> 4, c4 = (i & 15) * 4;
          *(f32x4*)(w2s + row * 64 + c4) = *(const f32x4*)(w2g + (size_t)row * 256 + c4); *(f32x4*)(a2s + row * 64 + c4) = *(const f32x4*)(a2g + (size_t)row * 256 + c4); } }
    __syncthreads();
    const bf16* P = (const bf16*)(A.ws + WS_P) + C_RW;
    const float* mu = A.in(I_RWMU) + l * 1024;
    const int hc = h * 64 + lane;
    const int colv[5] = {hc, 256 + hc, 512 + hc, 768 + lane, 832 + lane};
    float muv[5];
#pragma unroll
    for (int q = 0; q < 5; ++q) muv[q] = mu[colv[q]];
    const float w0 = A.in(I_RWW0)[(l * 2 + dir) * 256 + hc], a0 = A.in(I_RWA0)[(l * 2 + dir) * 256 + hc];
    const float kkw = A.in(I_RWKK)[l * 256 + hc], kaw = A.in(I_RWKA)[l * 256 + hc];
    const int sgn = dir ? -1 : 1;
    const int tkf = dir ? x.L - 1 - x.c * 128 : x.c * 128;
    float S[64], Pm[64];
#pragma unroll
    for (int k = 0; k < 64; ++k) { S[k] = 0.f; Pm[k] = (k == lane) ? 1.f : 0.f; }
    bf16* yo = (bf16*)(A.ws + WS_RWY) + ((size_t)dir * NTOK * 4) * 128;
    unsigned raw[10][3];
#define RW_LOADROW(i, tk0) do { const int t_ = (tk0) + sgn * ((i) - 1); const bool ok_ = (t_ >= 0) && (t_ < x.L); const bf16* p_ = P + (size_t)(x.seqbase + (ok_ ? t_ : 0)) * PINP; \
        const unsigned v0_ = p_[colv[0]], v1_ = p_[colv[1]], v2_ = p_[colv[2]], v3_ = p_[colv[3]], v4_ = p_[colv[4]]; \
        raw[i][0] = ok_ ? (v0_ | (v1_ << 16)) : 0u; raw[i][1] = ok_ ? (v2_ | (v3_ << 16)) : 0u; raw[i][2] = ok_ ? v4_ : 0u; } while (0)
#define RW_GET(i, q) ((q) == 0 ? lo16(raw[i][0]) : (q) == 1 ? hi16(raw[i][0]) : (q) == 2 ? lo16(raw[i][1]) : (q) == 3 ? hi16(raw[i][1]) : lo16(raw[i][2]))
#pragma unroll
    for (int i = 0; i < 10; ++i) RW_LOADROW(i, tkf);
#pragma unroll 1
    for (int j0 = 0; j0 < 128; j0 += 8) {
#pragma unroll
        for (int u = 0; u < 8; ++u) { float* o = wl + u * 384; float xs[5];
#pragma unroll
            for (int q = 0; q < 5; ++q) { const float c = RW_GET(u + 1, q); xs[q] = c + muv[q] * (0.5f * (RW_GET(u, q) + RW_GET(u + 2, q)) - c); }
            o[lane] = xs[0]; o[128 + lane] = xs[1]; o[320 + lane] = xs[2]; o[64 + lane] = tanhf(xs[3]); o[256 + lane] = xs[4]; }
#pragma unroll
        for (int q = 0; q < 3; ++q) { raw[0][q] = raw[8][q]; raw[1][q] = raw[9][q]; }
        if (j0 + 8 < 128) { const int tkn = tkf + sgn * (j0 + 8);
#pragma unroll
            for (int i = 2; i < 10; ++i) RW_LOADROW(i, tkn); }
        LDS_WAIT();
        float wacc[8], aacc[8];
#pragma unroll
        for (int u = 0; u < 8; ++u) { wacc[u] = w0; aacc[u] = a0; }
#pragma unroll 2
        for (int jr = 0; jr < 64; jr += 4) {
            const float w20 = w2s[jr * 64 + lane], w21 = w2s[(jr + 1) * 64 + lane], w22 = w2s[(jr + 2) * 64 + lane], w23 = w2s[(jr + 3) * 64 + lane];
            const float a20 = a2s[jr * 64 + lane], a21 = a2s[(jr + 1) * 64 + lane], a22 = a2s[(jr + 2) * 64 + lane], a23 = a2s[(jr + 3) * 64 + lane];
#pragma unroll
            for (int u = 0; u < 8; ++u) { const f32x4 t4 = *(const f32x4*)(wl + u * 384 + 64 + jr), l4 = *(const f32x4*)(wl + u * 384 + 256 + jr);
                wacc[u] += t4[0] * w20 + t4[1] * w21 + t4[2] * w22 + t4[3] * w23; aacc[u] += l4[0] * a20 + l4[1] * a21 + l4[2] * a22 + l4[3] * a23; } }
        LDS_WAIT();
#pragma unroll
        for (int u = 0; u < 8; ++u) {
            float* o = wl + u * 384;
            const float w = __expf(-0.606531f * sigmoidf_(wacc[u])), a = sigmoidf_(aacc[u]);
            const float kr = o[128 + lane];
            float kn = kr * kkw; const float nr = sqrtf(wave_sum(kn * kn)); kn = kn / fmaxf(nr, 1e-12f);
            o[64 + lane] = w; o[128 + lane] = kr * (1.0f + (a - 1.0f) * kaw); o[192 + lane] = -kn; o[256 + lane] = kn * a;
        }
        LDS_WAIT();
#pragma unroll 1
        for (int u = 0; u < 8; ++u) {
            const float* o = wl + u * 384;
            f32x4 sa4 = {0.f, 0.f, 0.f, 0.f}, sp4 = {0.f, 0.f, 0.f, 0.f}, sb4 = {0.f, 0.f, 0.f, 0.f}, sq4 = {0.f, 0.f, 0.f, 0.f};
            { f32x4 avc = *(const f32x4*)(o + 192), avn = avc;
#pragma unroll
              for (int k = 0; k < 64; k += 4) {
                  if (k + 4 < 64) avn = *(const f32x4*)(o + 192 + k + 4);
                  __builtin_amdgcn_sched_barrier(0);
                  if (k & 4) { sb4 += (f32x4){S[k], S[k + 1], S[k + 2], S[k + 3]} * avc; sq4 += (f32x4){Pm[k], Pm[k + 1], Pm[k + 2], Pm[k + 3]} * avc; }
                  else       { sa4 += (f32x4){S[k], S[k + 1], S[k + 2], S[k + 3]} * avc; sp4 += (f32x4){Pm[k], Pm[k + 1], Pm[k + 2], Pm[k + 3]} * avc; }
                  __builtin_amdgcn_sched_barrier(0);
                  avc = avn; } }
            sa4 += sb4; sp4 += sq4;
            const float sa = (sa4[0] + sa4[1]) + (sa4[2] + sa4[3]), sp = (sp4[0] + sp4[1]) + (sp4[2] + sp4[3]);
            const float vcur = o[320 + lane];
            f32x4 y4 = {0.f, 0.f, 0.f, 0.f}, u4 = {0.f, 0.f, 0.f, 0.f}, yb4 = {0.f, 0.f, 0.f, 0.f}, ub4 = {0.f, 0.f, 0.f, 0.f};
            { f32x4 wc = *(const f32x4*)(o + 64), bc = *(const f32x4*)(o + 256), kc = *(const f32x4*)(o + 128), rc = *(const f32x4*)(o), wn = wc, bn = bc, kn2 = kc, rn = rc;
#pragma unroll
              for (int k = 0; k < 64; k += 4) {
                  if (k + 4 < 64) { wn = *(const f32x4*)(o + 64 + k + 4); bn = *(const f32x4*)(o + 256 + k + 4); kn2 = *(const f32x4*)(o + 128 + k + 4); rn = *(const f32x4*)(o + k + 4); }
                  __builtin_amdgcn_sched_barrier(0);
#pragma unroll
                  for (int e = 0; e < 4; ++e) { S[k + e] = S[k + e] * wc[e] + sa * bc[e] + vcur * kc[e]; Pm[k + e] = Pm[k + e] * wc[e] + sp * bc[e]; }
                  if (k & 4) { yb4 += (f32x4){S[k], S[k + 1], S[k + 2], S[k + 3]} * rc; ub4 += (f32x4){Pm[k], Pm[k + 1], Pm[k + 2], Pm[k + 3]} * rc; }
                  else       { y4 += (f32x4){S[k], S[k + 1], S[k + 2], S[k + 3]} * rc; u4 += (f32x4){Pm[k], Pm[k + 1], Pm[k + 2], Pm[k + 3]} * rc; }
                  __builtin_amdgcn_sched_barrier(0);
                  wc = wn; bc = bn; kc = kn2; rc = rn; } }
            y4 += yb4; u4 += ub4;
            const float y = (y4[0] + y4[1]) + (y4[2] + y4[3]), uu = (u4[0] + u4[1]) + (u4[2] + u4[3]);
            const int tk = tkf + sgn * (j0 + u);
            bf16* yr = yo + ((size_t)(x.seqbase + tk) * 4 + h) * 128;
            yr[lane] = (bf16)f2bf(y); yr[64 + lane] = (bf16)f2bf(uu);
        }
        LDS_WAIT();
    }
#undef RW_LOADROW
#undef RW_GET
    float* pb = (float*)(A.ws + WS_RWB) + (size_t)it * 4096 + lane * 64;
    float* pp = (float*)(A.ws + WS_RWP) + (size_t)it * 4096 + lane * 64;
#pragma unroll
    for (int k = 0; k < 64; k += 4) { *(f32x4*)(pb + k) = (f32x4){S[k], S[k + 1], S[k + 2], S[k + 3]}; *(f32x4*)(pp + k) = (f32x4){Pm[k], Pm[k + 1], Pm[k + 2], Pm[k + 3]}; }
    __syncthreads();
}

__device__ __forceinline__ void rw_scan_chain(const KA& A, int l, int ch, unsigned char* lds, int tid) {
    const int g = ch >= 256, cl = g ? ch - 256 : ch, b = cl >> 3, h = (cl >> 1) & 3, dir = cl & 1, nc = g ? 32 : 2;
    const size_t sidx = (((size_t)(b * 4 + l) * 2 + dir) * 4 + h);
    float* Sl = (float*)lds;
    float* Pl = Sl + 2 * 64 * 68;
    const int v = tid >> 3, kq = tid & 7;
    float sown[8];
    { const float* s0 = A.in(I_RWS) + sidx * 4096 + v * 64 + kq * 8;
#pragma unroll
      for (int e = 0; e < 8; ++e) sown[e] = g ? s0[e] : 0.f; }
    __syncthreads();
#pragma unroll
    for (int e = 0; e < 8; ++e) Sl[v * 68 + kq * 8 + e] = sown[e];
    float pc[8], bc[8];
    { const int it = item_of(g, b, h, dir, 0); const float* pp = (const float*)(A.ws + WS_RWP) + (size_t)it * 4096 + tid * 8; const float* pb = (const float*)(A.ws + WS_RWB) + (size_t)it * 4096 + tid * 8;
#pragma unroll
      for (int e = 0; e < 8; ++e) { pc[e] = pp[e]; bc[e] = pb[e]; } }
    for (int c = 0; c < nc; ++c) {
        const int it = item_of(g, b, h, dir, c);
        const float* Sc = Sl + (c & 1) * 64 * 68; float* Sn = Sl + ((c + 1) & 1) * 64 * 68;
#pragma unroll
        for (int e = 0; e < 8; ++e) Pl[tid * 8 + e] = pc[e];
        float snew[8];
#pragma unroll
        for (int e = 0; e < 8; ++e) snew[e] = bc[e];
        { float* sb = (float*)(A.ws + WS_RWB) + (size_t)it * 4096 + tid * 8;
#pragma unroll
          for (int e = 0; e < 8; ++e) sb[e] = sown[e]; }
        if (c + 1 < nc) { const int i2 = item_of(g, b, h, dir, c + 1); const float* pp = (const float*)(A.ws + WS_RWP) + (size_t)i2 * 4096 + tid * 8; const float* pb = (const float*)(A.ws + WS_RWB) + (size_t)i2 * 4096 + tid * 8;
#pragma unroll
            for (int e = 0; e < 8; ++e) { pc[e] = pp[e]; bc[e] = pb[e]; } }
        __syncthreads();
        for (int k4 = 0; k4 < 64; k4 += 4) { const f32x4 sv = *(const f32x4*)(Sc + v * 68 + k4);
#pragma unroll
            for (int u = 0; u < 4; ++u) { const f32x4 p0 = *(const f32x4*)(Pl + (k4 + u) * 64 + kq * 8), p1 = *(const f32x4*)(Pl + (k4 + u) * 64 + kq * 8 + 4); const float s = sv[u];
                snew[0] += s * p0[0]; snew[1] += s * p0[1]; snew[2] += s * p0[2]; snew[3] += s * p0[3]; snew[4] += s * p1[0]; snew[5] += s * p1[1]; snew[6] += s * p1[2]; snew[7] += s * p1[3]; } }
#pragma unroll
        for (int e = 0; e < 8; ++e) { sown[e] = snew[e]; Sn[v * 68 + kq * 8 + e] = snew[e]; }
        __syncthreads();
    }
    if (!g) { float* o = A.out + O_RS + sidx * 4096 + v * 64 + kq * 8;
#pragma unroll
        for (int e = 0; e < 8; ++e) o[e] = sown[e]; }
}

__device__ __forceinline__ void rw_out_item(const KA& A, int l, int item, unsigned char* lds, int tid, int lane, int wave) {
    int g, b, h, tc, L, nc, seqbase;
    if (item < 256) { g = 0; tc = item & 1; const int bh = item >> 1; b = bh >> 2; h = bh & 3; L = 256; nc = 2; seqbase = b * 256; }
    else { const int i2 = item - 256; g = 1; tc = i2 & 31; const int bh = i2 >> 5; b = bh >> 2; h = bh & 3; L = 4096; nc = 32; seqbase = NCTX + b * 4096; }
    const bf16* P = (const bf16*)(A.ws + WS_P);
    const float* mu = A.in(I_RWMU) + l * 1024;
    const int hc = h * 64 + lane;
    const float kaw = A.in(I_RWKA)[l * 256 + hc], rkw = A.in(I_RWRK)[l * 256 + hc], lng = A.in(I_RWLNG)[l * 256 + hc], lnb = A.in(I_RWLNB)[l * 256 + hc];
    float* g2s = (float*)lds; float* a2s = g2s + 8192;
    { const float* g2g = A.in(I_RWG2) + (size_t)l * 128 * 256 + h * 64;
      for (int i = tid; i < 2048; i += NTHR) { const int row = i >> 4, c4 = (i & 15) * 4; *(f32x4*)(g2s + row * 64 + c4) = *(const f32x4*)(g2g + (size_t)row * 256 + c4); }
      for (int i = tid; i < 2048; i += NTHR) { const int row = i >> 4, c4 = (i & 15) * 4; const int d = row >> 6, jr = row & 63;
          *(f32x4*)(a2s + row * 64 + c4) = *(const f32x4*)(A.in(I_RWA2) + ((size_t)(l * 2 + d) * 64 + jr) * 256 + h * 64 + c4); } }
    __syncthreads();
    for (int rnd = 0; rnd < 2; ++rnd) {
        const int tk0 = tc * 128 + wave * 16 + rnd * 8;
        float rr[8], kk[8], vv[8], la[8], sg0[8], sg1[8], ysum[8], bon[8], gg[8];
#pragma unroll
        for (int u = 0; u < 8; ++u) { const int tk = tk0 + u;
            rr[u] = rw_shift(P, mu, seqbase, L, tk, hc); kk[u] = rw_shift(P, mu, seqbase, L, tk, 256 + hc); vv[u] = rw_shift(P, mu, seqbase, L, tk, 512 + hc);
            la[u] = rw_shift(P, mu, seqbase, L, tk, 832 + lane);
            sg0[u] = sigmoidf_(rw_shift(P, mu, seqbase, L, tk, 896 + lane)); sg1[u] = sigmoidf_(rw_shift(P, mu, seqbase, L, tk, 960 + lane));
            ysum[u] = 0.f; bon[u] = 0.f; gg[u] = 0.f; }
#pragma unroll 4
        for (int j = 0; j < 64; ++j) { const float g0v = g2s[j * 64 + lane], g1v = g2s[(64 + j) * 64 + lane];
#pragma unroll
            for (int u = 0; u < 8; ++u) gg[u] += rdl(sg0[u], j) * g0v + rdl(sg1[u], j) * g1v; }
        for (int dir = 0; dir < 2; ++dir) {
            const float a0 = A.in(I_RWA0)[(l * 2 + dir) * 256 + hc];
            float aacc[8];
#pragma unroll
            for (int u = 0; u < 8; ++u) aacc[u] = a0;
#pragma unroll 4
            for (int j = 0; j < 64; ++j) { const float a2v = a2s[(dir * 64 + j) * 64 + lane];
#pragma unroll
                for (int u = 0; u < 8; ++u) aacc[u] += rdl(la[u], j) * a2v; }
            const int c = dir ? nc - 1 - tc : tc;
            const float* s0 = (const float*)(A.ws + WS_RWB) + (size_t)item_of(g, b, h, dir, c) * 4096 + lane * 64;
            float S0[64];
#pragma unroll
            for (int k = 0; k < 64; k += 4) { const f32x4 t = *(const f32x4*)(s0 + k); S0[k] = t[0]; S0[k + 1] = t[1]; S0[k + 2] = t[2]; S0[k + 3] = t[3]; }
            const bf16* yo = (const bf16*)(A.ws + WS_RWY) + ((size_t)dir * NTOK * 4) * 128;
#pragma unroll
            for (int u = 0; u < 8; ++u) {
                const bf16* yr = yo + ((size_t)(seqbase + tk0 + u) * 4 + h) * 128;
                float y = bf2f(yr[lane]); const float uv = bf2f(yr[64 + lane]);
#pragma unroll
                for (int k = 0; k < 64; ++k) y += S0[k] * rdl(uv, k);
                ysum[u] += y;
                const float a = sigmoidf_(aacc[u]), kt = kk[u] * (1.0f + (a - 1.0f) * kaw);
                bon[u] += wave_sum(rr[u] * kt * rkw) * vv[u];
            }
        }
#pragma unroll
        for (int u = 0; u < 8; ++u) {
            const float mean = wave_sum(ysum[u]) * (1.f / 64.f), dl = ysum[u] - mean, var = wave_sum(dl * dl) * (1.f / 64.f);
            const float yn = dl * (1.0f / sqrtf(var + 64e-5f)) * lng + lnb;
            ((bf16*)(A.ws + WS_YC))[(size_t)(seqbase + tk0 + u) * 1024 + 512 + hc] = (bf16)f2bf((yn + bon[u]) * gg[u]);
        }
    }
    __syncthreads();
}

__device__ __forceinline__ void hy_out_item(const KA& A, int item, unsigned char* lds, int tid) {
    const int tile = item >> 2, cb = item & 3, m0 = tile * 64;
    bf16* T = (bf16*)lds;
    const bf16* yT = (const bf16*)(A.ws + WS_YT);
    { const int ch = tid >> 3, tg = tid & 7; const u32x4 w = *(const u32x4*)(yT + (size_t)(cb * 64 + ch) * NTOK + m0 + tg * 8);
      const unsigned ww[4] = {w.x, w.y, w.z, w.w};
#pragma unroll
      for (int e = 0; e < 4; ++e) { T[(tg * 8 + 2 * e) * 72 + ch] = (bf16)(ww[e] & 0xffffu); T[(tg * 8 + 2 * e + 1) * 72 + ch] = (bf16)(ww[e] >> 16); } }
    __syncthreads();
    { const int tok = tid >> 3, cg = tid & 7; const u32x4 w = *(const u32x4*)(T + tok * 72 + cg * 8);
      *(u32x4*)((bf16*)(A.ws + WS_YC) + (size_t)(m0 + tok) * 1024 + cb * 64 + cg * 8) = w; }
    __syncthreads();
}

typedef float f32x4v __attribute__((ext_vector_type(4)));
__device__ __forceinline__ void rw_out_mfma(const KA& A, int l, int item, unsigned char* lds, int tid, int lane, int wave) {
    int g, b, h, tc, L, nc, seqbase;
    if (item < 256) { g = 0; tc = item & 1; const int bh = item >> 1; b = bh >> 2; h = bh & 3; L = 256; nc = 2; seqbase = b * 256; }
    else { const int i2 = item - 256; g = 1; tc = i2 & 31; const int bh = i2 >> 5; b = bh >> 2; h = bh & 3; L = 4096; nc = 32; seqbase = NCTX + b * 4096; }
    bf16* SG = (bf16*)lds;
    bf16* LA = SG + 128 * 136;
    bf16* G2t = LA + 128 * 72;
    bf16* A2t = G2t + 64 * 136;
    const bf16* P = (const bf16*)(A.ws + WS_P) + C_RW;
    const float* mu = A.in(I_RWMU) + l * 1024;
    { const int tok = tid >> 2, part = tid & 3, tk = tc * 128 + tok;
      const bool hp = tk > 0, hn = tk < L - 1;
      const bf16* pr = P + (size_t)(seqbase + tk) * PINP;
#pragma unroll 2
      for (int ch = 0; ch < 6; ++ch) { const int col = 832 + part * 48 + ch * 8;
          float c8[8], p8[8], n8[8];
          unpack8(*(const u32x4*)(pr + col), c8);
          if (hp) unpack8(*(const u32x4*)(pr - PINP + col), p8); else { for (int e = 0; e < 8; ++e) p8[e] = 0.f; }
          if (hn) unpack8(*(const u32x4*)(pr + PINP + col), n8); else { for (int e = 0; e < 8; ++e) n8[e] = 0.f; }
          float o8[8];
#pragma unroll
          for (int e = 0; e < 8; ++e) { const float x = c8[e] + mu[col + e] * (0.5f * (p8[e] + n8[e]) - c8[e]); o8[e] = (col >= 896) ? sigmoidf_(x) : x; }
          u32x4 w; w.x = pk2(o8[0], o8[1]); w.y = pk2(o8[2], o8[3]); w.z = pk2(o8[4], o8[5]); w.w = pk2(o8[6], o8[7]);
          if (col >= 896) *(u32x4*)(SG + tok * 136 + (col - 896)) = w; else *(u32x4*)(LA + tok * 72 + (col - 832)) = w; } }
    { const float* g2g = A.in(I_RWG2) + (size_t)l * 128 * 256 + h * 64;
      for (int i = tid; i < 128 * 64; i += NTHR) { const int k = i >> 6, n = i & 63; G2t[n * 136 + k] = (bf16)f2bf(g2g[(size_t)k * 256 + n]); }
      for (int i = tid; i < 2 * 64 * 64; i += NTHR) { const int d = i >> 12, k = (i >> 6) & 63, n = i & 63; A2t[(d * 64 + n) * 72 + k] = (bf16)f2bf(A.in(I_RWA2)[((size_t)(l * 2 + d) * 64 + k) * 256 + h * 64 + n]); } }
    __syncthreads();
    const int fr = lane & 15, kg = lane >> 4, tb = wave * 16;
    f32x4v accG[4], accA[2][4], accY[2][4];
#pragma unroll
    for (int ct = 0; ct < 4; ++ct) { accG[ct] = (f32x4v){0.f, 0.f, 0.f, 0.f}; accA[0][ct] = accG[ct]; accA[1][ct] = accG[ct]; accY[0][ct] = accG[ct]; accY[1][ct] = accG[ct]; }
#pragma unroll
    for (int ks = 0; ks < 4; ++ks) { const bf16x8 af = *(const bf16x8*)(SG + (tb + fr) * 136 + ks * 32 + kg * 8);
#pragma unroll
        for (int ct = 0; ct < 4; ++ct) { const bf16x8 bfr = *(const bf16x8*)(G2t + (ct * 16 + fr) * 136 + ks * 32 + kg * 8); accG[ct] = __builtin_amdgcn_mfma_f32_16x16x32_bf16(af, bfr, accG[ct], 0, 0, 0); } }
#pragma unroll
    for (int ks = 0; ks < 2; ++ks) { const bf16x8 af = *(const bf16x8*)(LA + (tb + fr) * 72 + ks * 32 + kg * 8);
#pragma unroll
        for (int d = 0; d < 2; ++d)
#pragma unroll
            for (int ct = 0; ct < 4; ++ct) { const bf16x8 bfr = *(const bf16x8*)(A2t + (d * 64 + ct * 16 + fr) * 72 + ks * 32 + kg * 8); accA[d][ct] = __builtin_amdgcn_mfma_f32_16x16x32_bf16(af, bfr, accA[d][ct], 0, 0, 0); } }
#pragma unroll
    for (int d = 0; d < 2; ++d) {
        const int c = d ? nc - 1 - tc : tc;
        const float* s0 = (const float*)(A.ws + WS_RWB) + (size_t)item_of(g, b, h, d, c) * 4096;
        const bf16* yo = (const bf16*)(A.ws + WS_RWY) + ((size_t)d * NTOK * 4) * 128 + ((size_t)(seqbase + tc * 128 + tb + fr) * 4 + h) * 128 + 64;
#pragma unroll
        for (int ks = 0; ks < 2; ++ks) { const bf16x8 af = *(const bf16x8*)(yo + ks * 32 + kg * 8);
#pragma unroll
            for (int ct = 0; ct < 4; ++ct) { const float* sp = s0 + (ct * 16 + fr) * 64 + ks * 32 + kg * 8; const f32x4 s0a = *(const f32x4*)sp, s0b = *(const f32x4*)(sp + 4);
                u32x4 w; w.x = pk2(s0a[0], s0a[1]); w.y = pk2(s0a[2], s0a[3]); w.z = pk2(s0b[0], s0b[1]); w.w = pk2(s0b[2], s0b[3]);
                accY[d][ct] = __builtin_amdgcn_mfma_f32_16x16x32_bf16(af, __builtin_bit_cast(bf16x8, w), accY[d][ct], 0, 0, 0); } } }
    float prm[4][6];
#pragma unroll
    for (int ct = 0; ct < 4; ++ct) { const int hc = h * 64 + ct * 16 + fr;
        prm[ct][0] = A.in(I_RWA0)[(l * 2 + 0) * 256 + hc]; prm[ct][1] = A.in(I_RWA0)[(l * 2 + 1) * 256 + hc]; prm[ct][2] = A.in(I_RWKA)[l * 256 + hc];
        prm[ct][3] = A.in(I_RWRK)[l * 256 + hc]; prm[ct][4] = A.in(I_RWLNG)[l * 256 + hc]; prm[ct][5] = A.in(I_RWLNB)[l * 256 + hc]; }
#pragma unroll
    for (int rr = 0; rr < 4; ++rr) {
        const int tk = tc * 128 + tb + 4 * kg + rr; const size_t m = (size_t)(seqbase + tk);
        float ys[4], rv[4], kv[4], vv[4], d0 = 0.f, d1 = 0.f;
#pragma unroll
        for (int ct = 0; ct < 4; ++ct) { const int hc = h * 64 + ct * 16 + fr;
            rv[ct] = rw_shift(P - C_RW, mu, seqbase, L, tk, hc); kv[ct] = rw_shift(P - C_RW, mu, seqbase, L, tk, 256 + hc); vv[ct] = rw_shift(P - C_RW, mu, seqbase, L, tk, 512 + hc);
            const bf16* y0p = (const bf16*)(A.ws + WS_RWY) + (m * 4 + h) * 128 + ct * 16 + fr; const bf16* y1p = y0p + (size_t)NTOK * 4 * 128;
            ys[ct] = accY[0][ct][rr] + accY[1][ct][rr] + bf2f(y0p[0]) + bf2f(y1p[0]);
            const float a0v = sigmoidf_(accA[0][ct][rr] + prm[ct][0]), a1v = sigmoidf_(accA[1][ct][rr] + prm[ct][1]);
            d0 += rv[ct] * kv[ct] * (1.0f + (a0v - 1.0f) * prm[ct][2]) * prm[ct][3]; d1 += rv[ct] * kv[ct] * (1.0f + (a1v - 1.0f) * prm[ct][2]) * prm[ct][3]; }
        float s = (ys[0] + ys[1]) + (ys[2] + ys[3]), dd = d0 + d1;
#pragma unroll
        for (int o = 1; o < 16; o <<= 1) { s += __shfl_xor(s, o); dd += __shfl_xor(dd, o); }
        const float mean = s * (1.f / 64.f); float q = 0.f;
#pragma unroll
        for (int ct = 0; ct < 4; ++ct) { const float dl = ys[ct] - mean; q += dl * dl; }
#pragma unroll
        for (int o = 1; o < 16; o <<= 1) q += __shfl_xor(q, o);
        const float rstd = 1.0f / sqrtf(q * (1.f / 64.f) + 64e-5f);
#pragma unroll
        for (int ct = 0; ct < 4; ++ct) { const float yn = (ys[ct] - mean) * rstd * prm[ct][4] + prm[ct][5];
            ((bf16*)(A.ws + WS_YC))[m * 1024 + 512 + h * 64 + ct * 16 + fr] = (bf16)f2bf((yn + dd * vv[ct]) * accG[ct][rr]); }
    }
    __syncthreads();
}
#define LAS __attribute__((address_space(3)))
#define XB_TMO      128
#define XB_XCNT(j)  (256  + 64 * (j))
#define XB_XSUB(j)  (1280 + 64 * (j))
#define XB_XGEN(j)  (2304 + 64 * (j))
#define XB_TOP      3328
#define XB_TOPGEN   3392
#define XCD_BAR_WORDS 3456
#define XB_SPIN_CAP (1u << 18)

__device__ __forceinline__ unsigned xb_ld(unsigned* p)              { return __hip_atomic_load(p, __ATOMIC_RELAXED, __HIP_MEMORY_SCOPE_AGENT); }
__device__ __forceinline__ unsigned xb_add(unsigned* p, unsigned v) { return __hip_atomic_fetch_add(p, v, __ATOMIC_RELAXED, __HIP_MEMORY_SCOPE_AGENT); }
__device__ __forceinline__ unsigned xb_xcc_id() { return (unsigned)__builtin_amdgcn_s_getreg((3 << 11) | 20) & 0xFu; }
#define XB_SPIN(cond, bar) do { unsigned _sp = 0; while (cond) { __builtin_amdgcn_s_sleep(1); \
    if ((++_sp & 255u) == 0u) { if (xb_ld(&(bar)[XB_TMO])) break; if (_sp > XB_SPIN_CAP) { atomicAdd(&(bar)[XB_TMO], 1u); break; } } } } while (0)

struct XcdBarrier {
    unsigned* bar; unsigned x;
    volatile LAS unsigned* st;
};

__device__ __forceinline__ XcdBarrier xcd_barrier_post(unsigned* bar, volatile LAS unsigned* st) {
    XcdBarrier b; b.bar = bar; b.x = xb_xcc_id(); b.st = st;
    if (threadIdx.x == 0) (void)xb_add(&bar[XB_XCNT(b.x)], 1u);
    return b;
}
__device__ __forceinline__ void xcd_barrier_complete(unsigned* bar, unsigned x, unsigned& nloc, unsigned& nx) {
    const unsigned G = gridDim.x * gridDim.y * gridDim.z;
    unsigned sum, cnt, mine, sp = 0u;
    for (;;) {
        sum = 0u; cnt = 0u; mine = 0u;
#pragma unroll
        for (unsigned j = 0; j < 16; ++j) { const unsigned c = xb_ld(&bar[XB_XCNT(j)]); sum += c; cnt += (c > 0u) ? 1u : 0u; mine = (j == x) ? c : mine; }
        if (sum == G) break;
        __builtin_amdgcn_s_sleep(1);
        if ((++sp & 255u) == 0u) { if (xb_ld(&bar[XB_TMO])) break; if (sp > XB_SPIN_CAP) { atomicAdd(&bar[XB_TMO], 1u); break; } }
    }
    nloc = mine > 0u ? mine : 1u; nx = cnt > 0u ? cnt : 1u;
}

__device__ __forceinline__ void xcd_barrier(const XcdBarrier& b) {
    asm volatile("s_waitcnt vmcnt(0)" ::: "memory");
    __syncthreads();
    if (threadIdx.x == 0) {
        unsigned* bar = b.bar;
        __builtin_amdgcn_s_waitcnt(0);
        unsigned nloc = b.st[0], nx = b.st[1];
        if (nloc == 0u) { xcd_barrier_complete(bar, b.x, nloc, nx); b.st[0] = nloc; b.st[1] = nx; }
        const unsigned old = xb_add(&bar[XB_XSUB(b.x)], 1u);
        const unsigned gen = old / nloc;
        if (old + 1u == (gen + 1u) * nloc) {
            __builtin_amdgcn_fence(__ATOMIC_RELEASE, "agent");
            asm volatile("s_waitcnt vmcnt(0)" ::: "memory");
            const unsigned og = xb_add(&bar[XB_TOP], 1u);
            const unsigned tg = og / nx;
            if (og + 1u == (tg + 1u) * nx) xb_add(&bar[XB_TOPGEN], 1u);
            else XB_SPIN(xb_ld(&bar[XB_TOPGEN]) == tg, bar);
            __builtin_amdgcn_fence(__ATOMIC_ACQUIRE, "agent");
            xb_add(&bar[XB_XGEN(b.x)], 1u);
            asm volatile("s_waitcnt vmcnt(0)" ::: "memory");
        } else {
            XB_SPIN(xb_ld(&bar[XB_XGEN(b.x)]) == gen, bar);
            __builtin_amdgcn_fence(__ATOMIC_ACQUIRE, "agent");
            asm volatile("s_waitcnt vmcnt(0)" ::: "memory");
        }
    }
    __syncthreads();
}


#ifndef DBL
#define DBL (-1)
#endif
#ifndef DBL_SUB
#define DBL_SUB 1023
#endif
constexpr int CW_BAR = 4096;
#ifndef EN_HY
#define EN_HY 1
#endif
#ifndef EN_RWL
#define EN_RWL 1
#endif
#ifndef EN_AT
#define EN_AT 1
#endif
#ifndef EN_MLL
#define EN_MLL 1
#endif
#ifndef EN_RWO
#define EN_RWO 1
#endif
#ifndef EN_MLO
#define EN_MLO 1
#endif
#ifndef EN_P2
#define EN_P2 1
#endif
#ifndef EN_P4
#define EN_P4 1
#endif
#ifndef EN_GEMM
#define EN_GEMM 7
#endif

__device__ __forceinline__ int q_next(unsigned* head, unsigned char* lds, int tid) {
    volatile LAS int* slot = (volatile LAS int*)((LAS unsigned char*)lds + LDS_SLOT);
    __syncthreads();
    if (tid == 0) *slot = (int)atomicAdd(head, 1u);
    __syncthreads();
    return *slot;
}

__device__ __forceinline__ void phase3(const KA& A, int l, unsigned char* lds, int tid0, int wave, int qsel, unsigned tmask) {
    unsigned* head = (unsigned*)(A.ws + WS_CTL) + CW_Q + 64 * l + 32 * qsel;
    constexpr int N_HYL = 256, N_RW = 128, N_ATL = 128, N_HYC = 256, N_ATC = 128, N_ML = 1024;
    const int n_wc = (l < 3) ? 100 : 72;
    const int total = N_HYL + N_RW + N_ATL + N_HYC + N_ATC + N_ML + n_wc;
    for (;;) {
        int tid = tid0; asm volatile("" : "+v"(tid)); const int lane = tid & 63;
        unsigned long long hp_ = (unsigned long long)head; asm volatile("" : "+s"(hp_));
        int it = q_next((unsigned*)hp_, lds, tid);
        if (it >= total) break;
        if (it < N_RW) { if (tmask & 2u) rw_local_block(A, l, it, lds, tid, lane, wave); continue; } it -= N_RW;
        if (it < N_HYL) { if (tmask & 1u) hy_unit_mfma(A, l, 1, it, lds, tid, lane, wave); continue; } it -= N_HYL;
        if (it < N_ATL) { if (tmask & 4u) attn_unit(A, 1, it >> 6, (it >> 5) & 1, it & 31, lds, tid, lane, wave); continue; } it -= N_ATL;
        if (it < N_ML) { if (tmask & 32u) ml_local_item(A, l, it, lds, tid, lane, wave); continue; } it -= N_ML;
        if (it < N_HYC) { if (tmask & 8u) hy_unit_mfma(A, l, 0, it, lds, tid, lane, wave); continue; } it -= N_HYC;
        if (it < N_ATC) { if (tmask & 16u) attn_unit(A, 0, it >> 2, (it >> 1) & 1, it & 1, lds, tid, lane, wave); continue; } it -= N_ATC;
        if (!(tmask & 64u)) continue;
        if (it < 8) { wconv_block(A.in(I_WOUT) + (size_t)l * 1024 * 1024, 1024, 1024, 1024, (bf16*)(A.ws + WS_WOUT), it * 64, 64, lds, wave, lane); continue; } it -= 8;
        if (it < 32) { wconv_block(A.in(I_W1) + (size_t)l * 1024 * 4096, 1024, 4096, 4096, (bf16*)(A.ws + WS_W1), it * 64, 64, lds, wave, lane); continue; } it -= 32;
        if (it < 32) { wconv_block(A.in(I_W2) + (size_t)l * 4096 * 1024, 4096, 1024, 1024, (bf16*)(A.ws + WS_W2), it * 64, 64, lds, wave, lane); continue; } it -= 32;
        wconv_block(A.in(I_WIN) + (size_t)(l + 1) * 1024 * PIN, 1024, PIN, PINP, (bf16*)(A.ws + WS_WIN), it * 64, 64, lds, wave, lane);
    }
}
__device__ __forceinline__ void phase4(const KA& A, int l, unsigned char* lds, int tid0, int bid, int G) {
    for (int it = bid; it < 544; it += G) {
        int tid = tid0; asm volatile("" : "+v"(tid));
        if (it < 16) rw_scan_chain(A, l, 256 + it, lds, tid);
        else if (it < 32) ml_scan_chain(A, l, 256 + it - 16, tid);
        else if (it < 288) rw_scan_chain(A, l, it - 32, lds, tid);
        else ml_scan_chain(A, l, it - 288, tid);
        __syncthreads();
    }
}
__device__ __forceinline__ void phase5(const KA& A, int l, unsigned char* lds, int tid0, int wave, int bid, int G, unsigned tmask) {
    for (int it = bid; it < 2048; it += G) {
        int tid = tid0; asm volatile("" : "+v"(tid)); const int lane = tid & 63;
        if (it < 512) { if (tmask & 128u) rw_out_mfma(A, l, it, lds, tid, lane, wave); }
        else if (it < 1024) { if (tmask & 256u) ml_out_item(A, l, it - 512, lds, tid, lane, wave); }
        else if (tmask & 512u) hy_out_item(A, it - 1024, lds, tid);
    }
}

#define IN(k) (ph_lo <= (k) && (k) < ph_hi)
#define SEAM(k) do { if (IN(k) && IN((k) + 1)) xcd_barrier(xbar); } while (0)
#define LAUNDER() int tid = tid0, bid = bid0, G = G0; asm volatile("" : "+v"(tid)); asm volatile("" : "+s"(bid), "+s"(G)); \
        const int lane = tid & 63, wave = __builtin_amdgcn_readfirstlane(tid >> 6); (void)lane; (void)wave; \
        unsigned lofs_ = 0u; asm volatile("" : "+s"(lofs_)); unsigned char* lds = lds_base + lofs_; A.lds = lds; \
        unsigned char* ws = A.ws; const float* mod = (const float*)(ws + WS_MOD); (void)mod
#define NREP(s) ((s) == DBL ? 2 : 1)
template <int l> __device__ __forceinline__ void layer_prog(KA& A, unsigned char* lds_base, int tid0, int bid0, int G0, int ph_lo, int ph_hi, const XcdBarrier& xbar) {
        const int pb = 2 + l * 10;
        if (IN(pb + 0)) for (int rep = 0; rep < NREP(0); ++rep) { LAUNDER();
            pg8::Gemm g{(const bf16*)(ws + WS_H), (const bf16*)(ws + WS_WIN), NTOK, PINP, 1024}; pg8::StaticOrder S; S.init(NTOK, PINP, G, bid);
            pg8::EpiBf16<0> E{(bf16*)(ws + WS_P), PINP};
            pg8::gemm_phase<pg8::EpiBf16<0>, pg8::StaticOrder, true, true>((PG8_LAS unsigned char*)lds, g, S, E);
            if (rep + 1 < NREP(0)) xcd_barrier(xbar); }
        SEAM(pb + 0);
        if (IN(pb + 1)) for (int rep = 0; rep < NREP(1); ++rep) { LAUNDER(); phase2(A, l, lds, tid, bid, G); if (rep + 1 < NREP(1)) xcd_barrier(xbar); }
        SEAM(pb + 1);
        if (IN(pb + 2)) for (int rep = 0; rep < NREP(2); ++rep) { LAUNDER(); phase3(A, l, lds, tid, wave, rep, rep ? (unsigned)DBL_SUB : 1023u); if (rep + 1 < NREP(2)) xcd_barrier(xbar); }
        SEAM(pb + 2);
        if (IN(pb + 3)) { LAUNDER(); phase4(A, l, lds, tid, bid, G); }
        SEAM(pb + 3);
        if (IN(pb + 4)) for (int rep = 0; rep < NREP(4); ++rep) { LAUNDER(); phase5(A, l, lds, tid, wave, bid, G, rep ? (unsigned)DBL_SUB : 1023u); if (rep + 1 < NREP(4)) xcd_barrier(xbar); }
        SEAM(pb + 4);
        if (IN(pb + 5)) { LAUNDER(); const float* modl = mod + (size_t)l * 3 * 6144;
            pg8::Gemm g{(const bf16*)(ws + WS_YC), (const bf16*)(ws + WS_WOUT), NTOK, 1024, 1024}; pg8::StaticOrder S; S.init(NTOK, 1024, G, bid);
            const float* b0 = (l == 0) ? A.in(I_XP) : A.out; const float* b1 = (l == 0) ? A.in(I_XS) : A.out + (size_t)NCTX * 1024;
            pg8::EpiRes E{b0, b1, A.out, modl + 2 * 1024, ALPHA};
            pg8::gemm_phase<pg8::EpiRes, pg8::StaticOrder, true, true>((PG8_LAS unsigned char*)lds, g, S, E); }
        SEAM(pb + 5);
        if (IN(pb + 6)) { LAUNDER(); const float* modl = mod + (size_t)l * 3 * 6144; phase_ln(A, A.in(I_LN1G) + l * 1024, A.in(I_LN1B) + l * 1024, modl, 3 * 1024, wave, lane, bid, G); }
        SEAM(pb + 6);
        if (IN(pb + 7)) for (int rep = 0; rep < NREP(7); ++rep) { LAUNDER();
            pg8::Gemm g{(const bf16*)(ws + WS_H), (const bf16*)(ws + WS_W1), NTOK, DFF, 1024}; pg8::StaticOrder S; S.init(NTOK, DFF, G, bid);
            pg8::EpiBf16<2> E{(bf16*)(ws + WS_P), DFF};
            pg8::gemm_phase<pg8::EpiBf16<2>, pg8::StaticOrder, true, true>((PG8_LAS unsigned char*)lds, g, S, E);
            if (rep + 1 < NREP(7)) xcd_barrier(xbar); }
        SEAM(pb + 7);
        if (IN(pb + 8)) { LAUNDER(); const float* modl = mod + (size_t)l * 3 * 6144;
            pg8::Gemm g{(const bf16*)(ws + WS_P), (const bf16*)(ws + WS_W2), NTOK, 1024, 4096}; pg8::StaticOrder S; S.init(NTOK, 1024, G, bid);
            pg8::EpiRes E{A.out, A.out + (size_t)NCTX * 1024, A.out, modl + 5 * 1024, ALPHA};
            pg8::gemm_phase<pg8::EpiRes, pg8::StaticOrder, true, true>((PG8_LAS unsigned char*)lds, g, S, E); }
        SEAM(pb + 8);
        if (IN(pb + 9)) { LAUNDER(); const float* modl = mod + (size_t)l * 3 * 6144; phase_ln(A, A.in(I_LN2G) + l * 1024, A.in(I_LN2B) + l * 1024, l < 3 ? modl + 3 * 6144 : nullptr, 0, wave, lane, bid, G); }
        SEAM(pb + 9);
}

__global__ void __launch_bounds__(NTHR, 2) mega_fwd(Args KARG) {
    extern __shared__ __attribute__((aligned(16))) unsigned char lds_base[];
    cg::grid_group grid = cg::this_grid();
    const int tid0 = threadIdx.x, bid0 = blockIdx.x, G0 = gridDim.x;
    { const int tid = tid0; unsigned long long pv = 0ull;
#pragma unroll
      for (int i = 0; i < 43; ++i) pv = (tid == i) ? (unsigned long long)KARG.in[i] : pv;
      if (tid < 43) *(unsigned long long*)(lds_base + LDS_TAB + tid * 8) = pv; }
    __syncthreads();
    KA A; A.out = KARG.out; A.ws = KARG.ws; A.lds = lds_base;
    const int ph_lo = KARG.ph_lo, ph_hi = KARG.ph_hi;
    if (tid0 < 2) ((volatile LAS unsigned*)lds_base)[(LDS_BYTES - 32) / 4 + tid0] = 0u;
    __syncthreads();
    XcdBarrier xbar = xcd_barrier_post((unsigned*)(KARG.ws + WS_CTL) + CW_BAR, (volatile LAS unsigned*)lds_base + (LDS_BYTES - 32) / 4);
    if (IN(0)) { LAUNDER(); phase0(A, lds, tid, wave, lane, bid, G); }
    if (IN(0) && IN(1)) grid.sync();
    if (IN(1)) { LAUNDER(); phase_mod0(A, wave, lane, bid, G); }
    SEAM(1);
    layer_prog<0>(A, lds_base, tid0, bid0, G0, ph_lo, ph_hi, xbar);
    layer_prog<1>(A, lds_base, tid0, bid0, G0, ph_lo, ph_hi, xbar);
    layer_prog<2>(A, lds_base, tid0, bid0, G0, ph_lo, ph_hi, xbar);
    layer_prog<3>(A, lds_base, tid0, bid0, G0, ph_lo, ph_hi, xbar);
#undef IN
#undef SEAM
#undef LAUNDER
#undef NREP
}

constexpr int N_PHASES = 42;
extern "C" void kernel_launch(void* const* d_in, const int* in_sizes, int n_in, void* d_out, int out_size, void* d_ws, size_t ws_size, hipStream_t stream) {
    static int grid = 0;
    if (grid == 0) {
        if (n_in != 43 || ws_size < WS_END) { fprintf(stderr, "kernel_launch: unexpected inputs (n_in %d, ws %zu)\n", n_in, ws_size); grid = -1; return; }
        int dev = 0, cus = 0, per_cu = 0;
        hipGetDevice(&dev);
        hipDeviceGetAttribute(&cus, hipDeviceAttributeMultiprocessorCount, dev);
        if (hipFuncSetAttribute((const void*)mega_fwd, hipFuncAttributeMaxDynamicSharedMemorySize, LDS_BYTES) != hipSuccess) { fprintf(stderr, "kernel_launch: hipFuncSetAttribute failed\n"); grid = -1; return; }
        hipOccupancyMaxActiveBlocksPerMultiprocessor(&per_cu, (const void*)mega_fwd, NTHR, LDS_BYTES);
        (void)hipGetLastError();
        if (per_cu < 1) { fprintf(stderr, "kernel_launch: occupancy query says %d blocks per CU\n", per_cu); per_cu = 1; }
        grid = cus;
    }
    if (grid < 0) return;
    hipMemsetAsync((char*)d_ws + WS_CTL, 0, 65536, stream);
    Args a{};
    for (int i = 0; i < 43; ++i) a.in[i] = (const float*)d_in[i];
    a.out = (float*)d_out; a.ws = (unsigned char*)d_ws;
#ifndef MK_SPLIT
    a.ph_lo = 0; a.ph_hi = N_PHASES;
    void* args[] = {&a};
    hipError_t e = hipLaunchCooperativeKernel((const void*)mega_fwd, dim3(grid), dim3(NTHR), args, LDS_BYTES, stream);
    if (e != hipSuccess) fprintf(stderr, "cooperative launch failed: %s (grid %d)\n", hipGetErrorString(e), grid);
#else
    for (int ph = 0; ph < N_PHASES; ++ph) { a.ph_lo = ph; a.ph_hi = ph + 1; hipLaunchKernelGGL(mega_fwd, dim3(grid), dim3(NTHR), LDS_BYTES, stream, a); }
#endif
}
```
